# Optimizing an MI355X kernel written in HIP

```python
import jax, jax.numpy as jnp
from jax import lax
import numpy as np

D_MODEL = 1024
BATCH = 2
SEQ = 16384
DEPTH = 4

CHUNK = 64
SGU_BLOCK = 128
D_A = 1024
A_GROUPS = 8
A_GROUP_DIM = D_A // A_GROUPS
D_B = 1024
POOL_WINDOWS = (2, 4, 8, 16)
B_GROUPS = len(POOL_WINDOWS)
B_GROUP_DIM = D_B // B_GROUPS
D_C = 1024
CONV_WIDTH = 3
N_BRANCH = 3
SPLIT_SIZES = (D_A, D_A, D_A, D_B, D_B, D_C, D_C, D_C, D_C, N_BRANCH * D_MODEL)
N_IN = sum(SPLIT_SIZES)
SPLIT_OFFSETS = tuple(int(o) for o in np.cumsum(SPLIT_SIZES)[:-1])
RMS_EPS = 1e-6
LN_EPS = 1e-5

kernel_name = "hybrid_gated_parallel_mixers"


def rmsnorm(x, g):
    xf = x.astype(jnp.float32)
    y = xf * lax.rsqrt(jnp.mean(xf * xf, axis=-1, keepdims=True) + RMS_EPS)
    return (y * g.astype(jnp.float32)).astype(x.dtype)


def layernorm(x, g, b):
    xf = x.astype(jnp.float32)
    mu = jnp.mean(xf, axis=-1, keepdims=True)
    var = jnp.mean(jnp.square(xf - mu), axis=-1, keepdims=True)
    y = (xf - mu) * lax.rsqrt(var + LN_EPS)
    return (y * g.astype(jnp.float32) + b.astype(jnp.float32)).astype(x.dtype)


def chunk_causal_mask():
    c = jnp.arange(SGU_BLOCK) // CHUNK
    return c[None, :] <= c[:, None]


def spatial_gating(u, v, w_s, b_s, ln_g, ln_b):
    bsz, s, _ = v.shape
    v = layernorm(v, ln_g, ln_b)
    vb = v.reshape(bsz, s // SGU_BLOCK, SGU_BLOCK, A_GROUPS, A_GROUP_DIM)
    w = jnp.where(chunk_causal_mask()[None], w_s, jnp.zeros_like(w_s))
    mixed = jnp.einsum('gij,bnjgc->bnigc', w, vb) + b_s.T[:, :, None]
    return u * mixed.reshape(bsz, s, D_A)


def multiscale_pool(p, w_g, b_g, scale):
    bsz, s, _ = p.shape
    pf = p.astype(jnp.float32)
    csum = jnp.cumsum(pf, axis=1)
    pos1 = jnp.arange(1, s + 1, dtype=jnp.int32)
    outs = []
    for k, win in enumerate(POOL_WINDOWS):
        sl = slice(k * B_GROUP_DIM, (k + 1) * B_GROUP_DIM)
        cg = csum[..., sl]
        shifted = jnp.pad(cg, ((0, 0), (win, 0), (0, 0)))[:, :s]
        count = jnp.minimum(pos1, win).astype(jnp.float32)[:, None]
        outs.append((cg - shifted) / count - pf[..., sl])
    d = jnp.concatenate(outs, axis=-1).astype(p.dtype)
    d = d.reshape(bsz, s, B_GROUPS, B_GROUP_DIM)
    y = jnp.einsum('bsgc,gcd->bsgd', d, w_g).reshape(bsz, s, D_B) + b_g
    return y * scale


def causal_depthwise_conv(h, w, b):
    s = h.shape[1]
    hp = jnp.pad(h, ((0, 0), (CONV_WIDTH - 1, 0), (0, 0)))
    y = sum(w[k] * hp[:, k:k + s] for k in range(CONV_WIDTH))
    return y + b


def setup_inputs(seed: int = 0) -> dict:
    key = jax.random.key(seed)
    ks = jax.random.split(key, 20)

    def nrm(k, shape, scale):
        return jax.random.normal(k, shape, jnp.float32) * scale

    L = DEPTH
    return {
        "x": nrm(ks[0], (BATCH, SEQ, D_MODEL), 1.0),
        "norm_g": 1.0 + nrm(ks[1], (L, D_MODEL), 0.05),
        "w_in": nrm(ks[2], (L, D_MODEL, N_IN), D_MODEL ** -0.5),
        "sgu_ln_g": 1.0 + nrm(ks[3], (L, D_A), 0.05),
        "sgu_ln_b": nrm(ks[4], (L, D_A), 0.02),
        "sgu_w": nrm(ks[5], (L, A_GROUPS, SGU_BLOCK, SGU_BLOCK), SGU_BLOCK ** -0.5),
        "sgu_b": 1.0 + nrm(ks[6], (L, A_GROUPS, SGU_BLOCK), 0.05),
        "pool_w": nrm(ks[7], (L, B_GROUPS, B_GROUP_DIM, B_GROUP_DIM), B_GROUP_DIM ** -0.5),
        "pool_b": nrm(ks[8], (L, D_B), 0.01),
        "pool_scale": 1.0 + nrm(ks[9], (L, D_B), 0.1),
        "conv_w": nrm(ks[10], (L, CONV_WIDTH, D_C), CONV_WIDTH ** -0.5),
        "conv_b": nrm(ks[11], (L, D_C), 0.01),
        "w_branch_a": nrm(ks[12], (L, D_A, D_MODEL), D_A ** -0.5),
        "w_branch_b": nrm(ks[13], (L, D_B, D_MODEL), D_B ** -0.5),
        "w_branch_c": nrm(ks[14], (L, D_C, D_MODEL), D_C ** -0.5),
        "w_out": nrm(ks[15], (L, D_MODEL, D_MODEL), D_MODEL ** -0.5),
        "final_g": 1.0 + nrm(ks[16], (D_MODEL,), 0.05),
    }


def reference(x, norm_g, w_in, sgu_ln_g, sgu_ln_b, sgu_w, sgu_b, pool_w, pool_b,
              pool_scale, conv_w, conv_b, w_branch_a, w_branch_b, w_branch_c,
              w_out, final_g):
    bsz, s, _ = x.shape
    for l in range(DEPTH):
        h = rmsnorm(x, norm_g[l])
        proj = jnp.einsum('bsd,dn->bsn', h, w_in[l])
        a_u, a_v, a_z, b_p, b_z, c_h, c_b, c_c, c_z, gate_logits = jnp.split(
            proj, SPLIT_OFFSETS, axis=-1)

        ya = spatial_gating(jax.nn.gelu(a_u), jax.nn.gelu(a_v), sgu_w[l], sgu_b[l],
                            sgu_ln_g[l], sgu_ln_b[l]) * jax.nn.silu(a_z)
        yb = multiscale_pool(b_p, pool_w[l], pool_b[l], pool_scale[l]) * jax.nn.silu(b_z)
        yc = c_b * causal_depthwise_conv(c_c * c_h, conv_w[l], conv_b[l]) * jax.nn.silu(c_z)

        gates = jax.nn.sigmoid(gate_logits.reshape(bsz, s, N_BRANCH, D_MODEL))
        merged = (gates[:, :, 0] * jnp.einsum('bsc,cd->bsd', ya, w_branch_a[l])
                  + gates[:, :, 1] * jnp.einsum('bsc,cd->bsd', yb, w_branch_b[l])
                  + gates[:, :, 2] * jnp.einsum('bsc,cd->bsd', yc, w_branch_c[l]))
        x = x + jnp.einsum('bsd,de->bse', merged, w_out[l])
    return rmsnorm(x, final_g)
```

```cpp
#include <hip/hip_runtime.h>
#include <hip/hip_cooperative_groups.h>
#include <cstdio>
#include <cstdint>
namespace cg = cooperative_groups;

#ifndef MK_MULTI_LAUNCH
#define MK_MULTI_LAUNCH 0
#endif

#define LAS __attribute__((address_space(3)))
typedef unsigned short bf16_t;
typedef short bf16x8 __attribute__((ext_vector_type(8)));
typedef short s16x4 __attribute__((ext_vector_type(4)));
typedef float f32x4 __attribute__((ext_vector_type(4)));
typedef float f32x2 __attribute__((ext_vector_type(2)));
typedef unsigned u32x4 __attribute__((ext_vector_type(4)));
typedef unsigned u32x2 __attribute__((ext_vector_type(2)));

constexpr int DM = 1024, SEQ = 16384, NBATCH = 2, MTOK = NBATCH * SEQ, DEPTH = 4, NIN = 12288;
constexpr int LDP = 1024;
constexpr size_t SEG = (size_t)MTOK * 1024;
constexpr size_t S_YA = 0, S_GV = 1 * SEG, S_BP = 2 * SEG, S_BZ = 3 * SEG, S_Q = 4 * SEG, S_G0 = 5 * SEG, S_CBZ = 6 * SEG, S_G1 = 7 * SEG, S_G2 = 8 * SEG;
constexpr size_t S_MG = S_Q, Y_STRIDE = 3 * SEG;
constexpr float RMS_EPS = 1e-6f, LN_EPS = 1e-5f;

constexpr size_t MiB = 1u << 20;
constexpr size_t WS_H = 0;
constexpr size_t WS_WIN = 64 * MiB;
constexpr size_t WS_WABC = 88 * MiB;
constexpr size_t WS_WOUT = 94 * MiB;
constexpr size_t WS_POOL = 96 * MiB;
constexpr size_t WS_SGW = 96 * MiB + 512 * 1024;
constexpr size_t WS_P = 128 * MiB;
constexpr size_t WS_BAR = 100 * MiB;
constexpr size_t WS_XR = 704 * MiB;
constexpr size_t WS_END = 768 * MiB;

constexpr int NWAVES = 8, NTHREADS = 512;
constexpr int LDS_MISC = 139264;
constexpr int LDS_BYTES = LDS_MISC + 256;

__device__ __forceinline__ unsigned cvt_pk_bf16(float lo, float hi) { unsigned r; asm volatile("v_cvt_pk_bf16_f32 %0, %1, %2" : "=v"(r) : "v"(lo), "v"(hi)); return r; }
__device__ __forceinline__ float bf_lo(unsigned u) { return __builtin_bit_cast(float, u << 16); }
__device__ __forceinline__ float bf_hi(unsigned u) { return __builtin_bit_cast(float, u & 0xffff0000u); }
__device__ __forceinline__ float sigmoid_f(float x) { return __builtin_amdgcn_rcpf(1.0f + __builtin_amdgcn_exp2f(-1.4426950409f * x)); }
__device__ __forceinline__ float wave_sum(float v) {
#pragma unroll
    for (int o = 1; o < 64; o <<= 1) v += __shfl_xor(v, o);
    return v;
}
#define LDS_WAIT() asm volatile("s_waitcnt lgkmcnt(0)" ::: "memory")

namespace pg8 {
constexpr int BM = 256, BK = 64, HALF = 128, HTB = HALF * BK * 2, STAGE_BYTES = 8 * HTB, NXCD = 8;
__host__ __device__ __forceinline__ int lds_byte(int r, int c) { const int st = (r >> 4) * 2 + (c >> 5), rr = r & 15, cc = c & 31, ob = rr * 64 + cc * 2; return st * 1024 + (ob ^ (((ob >> 9) & 1) << 5)); }
__host__ __device__ __forceinline__ void stage_rc(int b, int& R, int& C) { const int st = b / 1024, sb = b % 1024, swz = sb ^ (((sb >> 9) & 1) << 5); R = (st >> 1) * 16 + swz / 64; C = (st & 1) * 32 + (swz % 64) / 2; }
__host__ __device__ __forceinline__ int perm32(int rho) { const int n = rho >> 4, i = rho & 15; return 8 * (i >> 2) + 4 * n + (i & 3); }

struct Unit { int pm, pn, b; };
struct Gemm { const bf16_t* A; const bf16_t* Bt; int lda, K; size_t abs, bbs; };

struct TileOrder {
    int nM, nN, nwg, G, c, nb, WGM;
    __device__ void init(int M, int N, int G_, int c_, int nb_, int wgm_) { nM = M / BM; nN = N / BM; nwg = nM * nN; G = G_; c = c_; nb = nb_; WGM = wgm_; }
    __device__ bool next(int i, Unit& u) const {
        int t = i, b = 0; if (nb == 3) { t = i / 3; b = i - 3 * t; }
        const long L = (long)t * G + c; if (L >= nwg) return false;
        int wgid = (int)L; { const int q = nwg / NXCD, r = nwg % NXCD, xcd = wgid % NXCD, off = wgid / NXCD; wgid = (xcd < r ? xcd * (q + 1) : r * (q + 1) + (xcd - r) * q) + off; }
        const int nig = WGM * nN, gid = wgid / nig, fm = gid * WGM, gsz = (nM - fm) < WGM ? (nM - fm) : WGM;
        u.pm = fm + ((wgid % nig) % gsz); u.pn = (wgid % nig) / gsz; u.b = b; return true;
    }
};


struct EpiProj {
    static constexpr bool PERM = true, CHAIN = false;
    bf16_t* O;
    __device__ __forceinline__ void operator()(f32x4 (&acc)[2][2][4][2], const Unit& u, int wr, int wc, int fr, int fq) const {
        const int pn = u.pn;
        int mode; size_t ocol;
        if (pn < 8)       { mode = 4; ocol = S_YA + pn * 128; }
        else if (pn < 12) { mode = 1; ocol = S_GV + (pn - 8) * 256; }
        else if (pn < 16) { mode = 0; ocol = S_BP + (pn - 12) * 256; }
        else if (pn < 24) { mode = 5; ocol = S_Q + (pn - 16) * 128; }
        else if (pn < 32) { mode = 6; ocol = S_CBZ + (pn - 24) * 128; }
        else              { mode = 7; ocol = 0; }
        if (mode == 7) {
            const int row0q = u.pm * BM + wr * 64 + fr; const int ch = 64 * (pn - 32) + 16 * wc + 4 * fq;
#pragma unroll
            for (int ai = 0; ai < 2; ++ai)
#pragma unroll
                for (int m = 0; m < 4; ++m) {
                    bf16_t* rowp = O + (size_t)(row0q + ai * HALF + m * 16) * LDP + ch;
                    float r0v[4], r1v[4], g2v[4], szv[4];
#pragma unroll
                    for (int j = 0; j < 4; ++j) {
                        const float ea = fminf(__builtin_amdgcn_exp2f(-1.4426950409f * acc[ai][0][m][0][j]), 1e30f);
                        const float eb = fminf(__builtin_amdgcn_exp2f(-1.4426950409f * acc[ai][0][m][1][j]), 1e30f);
                        const float ec = fminf(__builtin_amdgcn_exp2f(-1.4426950409f * acc[ai][1][m][0][j]), 1e30f);
                        const float xz = acc[ai][1][m][1][j];
                        const float ia = __builtin_amdgcn_rcpf(1.0f + ea), ib = __builtin_amdgcn_rcpf(1.0f + eb), ic = __builtin_amdgcn_rcpf(1.0f + ec);
                        r0v[j] = (1.0f + eb) * ia; r1v[j] = (1.0f + ec) * ib; g2v[j] = ic; szv[j] = xz * sigmoid_f(xz);
                    }
                    u32x2 wr0, wr1, wg2, wsz;
                    wr0.x = cvt_pk_bf16(r0v[0], r0v[1]); wr0.y = cvt_pk_bf16(r0v[2], r0v[3]);
                    wr1.x = cvt_pk_bf16(r1v[0], r1v[1]); wr1.y = cvt_pk_bf16(r1v[2], r1v[3]);
                    wg2.x = cvt_pk_bf16(g2v[0], g2v[1]); wg2.y = cvt_pk_bf16(g2v[2], g2v[3]);
                    wsz.x = cvt_pk_bf16(szv[0], szv[1]); wsz.y = cvt_pk_bf16(szv[2], szv[3]);
                    const bool odd = (fq & 1) != 0;
                    const u32x2 s0 = odd ? wr0 : wg2, s1 = odd ? wr1 : wsz;
                    u32x2 q0, q1;
                    q0.x = (unsigned)__shfl_xor((int)s0.x, 16); q0.y = (unsigned)__shfl_xor((int)s0.y, 16);
                    q1.x = (unsigned)__shfl_xor((int)s1.x, 16); q1.y = (unsigned)__shfl_xor((int)s1.y, 16);
                    u32x4 o0, o1;
                    if (!odd) { o0 = (u32x4){wr0.x, wr0.y, q0.x, q0.y}; o1 = (u32x4){wr1.x, wr1.y, q1.x, q1.y}; }
                    else      { o0 = (u32x4){q0.x, q0.y, wg2.x, wg2.y}; o1 = (u32x4){q1.x, q1.y, wsz.x, wsz.y}; }
                    bf16_t* rp8 = rowp - (odd ? 4 : 0);
                    *(u32x4*)(rp8 + (odd ? S_G2 : S_G0)) = o0;
                    *(u32x4*)(rp8 + (odd ? S_BZ : S_G1)) = o1;
                }
            return;
        }
        const int row0 = u.pm * BM + wr * 64 + fr; const size_t col0 = ocol + wc * 32 + 8 * fq;
        if (mode >= 4) {
#pragma unroll
            for (int ai = 0; ai < 2; ++ai)
#pragma unroll
                for (int m = 0; m < 4; ++m) { bf16_t* rowp = O + (size_t)(row0 + ai * HALF + m * 16) * LDP + col0;
                    float v[8];
#pragma unroll
                    for (int j = 0; j < 8; ++j) {
                        const float x0 = acc[ai][0][m][j >> 2][j & 3], x1 = acc[ai][1][m][j >> 2][j & 3];
                        const float f0 = (mode == 4) ? x0 * sigmoid_f(1.5957691216f * (x0 + 0.044715f * x0 * x0 * x0)) : x0;
                        const float f1 = (mode == 5) ? x1 : x1 * sigmoid_f(x1);
                        v[j] = f0 * f1;
                    }
                    u32x4 w; w.x = cvt_pk_bf16(v[0], v[1]); w.y = cvt_pk_bf16(v[2], v[3]); w.z = cvt_pk_bf16(v[4], v[5]); w.w = cvt_pk_bf16(v[6], v[7]);
                    *(u32x4*)rowp = w; }
        } else {
#pragma unroll
            for (int ai = 0; ai < 2; ++ai)
#pragma unroll
                for (int m = 0; m < 4; ++m) { bf16_t* rowp = O + (size_t)(row0 + ai * HALF + m * 16) * LDP + col0;
#pragma unroll
                    for (int bj = 0; bj < 2; ++bj) {
                        float v[8];
#pragma unroll
                        for (int j = 0; j < 4; ++j) { v[j] = acc[ai][bj][m][0][j]; v[4 + j] = acc[ai][bj][m][1][j]; }
                        if (mode != 0) {
#pragma unroll
                            for (int j = 0; j < 8; ++j) {
                                const float x = v[j];
                                const float a = (mode == 1) ? 1.5957691216f * (x + 0.044715f * x * x * x) : x;
                                const float sg = sigmoid_f(a);
                                v[j] = (mode == 3) ? sg : x * sg;
                            }
                        }
                        u32x4 w; w.x = cvt_pk_bf16(v[0], v[1]); w.y = cvt_pk_bf16(v[2], v[3]); w.z = cvt_pk_bf16(v[4], v[5]); w.w = cvt_pk_bf16(v[6], v[7]);
                        *(u32x4*)(rowp + bj * HALF) = w; } }
        }
    }
};
struct EpiGate {
    static constexpr bool PERM = true, CHAIN = true;
    bf16_t* P;
    __device__ __forceinline__ void operator()(f32x4 (&acc)[2][2][4][2], const Unit& u, int wr, int wc, int fr, int fq) const {
        const int b = u.b; const size_t goff = (b == 0) ? S_G0 : (b == 1 ? S_G1 : S_G2);
        const int row0 = u.pm * BM + wr * 64 + fr, col0 = u.pn * BM + wc * 32 + 8 * fq;
        const bf16_t* gb = P + goff + (size_t)(u.pm * BM + wr * 64) * LDP + u.pn * BM;
        const unsigned go = (unsigned)(fr * LDP + wc * 32 + 8 * fq);
        u32x4 gw[2][4][2];
#pragma unroll
        for (int ai = 0; ai < 2; ++ai)
#pragma unroll
            for (int m = 0; m < 4; ++m)
#pragma unroll
                for (int bj = 0; bj < 2; ++bj) gw[ai][m][bj] = *(const u32x4*)(gb + (ai * HALF + m * 16) * LDP + bj * HALF + go);
#pragma unroll
        for (int ai = 0; ai < 2; ++ai)
#pragma unroll
            for (int m = 0; m < 4; ++m)
#pragma unroll
                for (int bj = 0; bj < 2; ++bj) {
                    const u32x4 g = gw[ai][m][bj];
                    f32x4 v0 = acc[ai][bj][m][0], v1 = acc[ai][bj][m][1];
                    v0[0] *= bf_lo(g.x); v0[1] *= bf_hi(g.x); v0[2] *= bf_lo(g.y); v0[3] *= bf_hi(g.y); v1[0] *= bf_lo(g.z); v1[1] *= bf_hi(g.z); v1[2] *= bf_lo(g.w); v1[3] *= bf_hi(g.w);
                    if (b != 2) { acc[ai][bj][m][0] = v0; acc[ai][bj][m][1] = v1; }
                    else { u32x4 w; w.x = cvt_pk_bf16(v0[0], v0[1]); w.y = cvt_pk_bf16(v0[2], v0[3]); w.z = cvt_pk_bf16(v1[0], v1[1]); w.w = cvt_pk_bf16(v1[2], v1[3]);
                        *(u32x4*)(P + (size_t)(row0 + ai * HALF + m * 16) * LDP + S_MG + col0 + bj * HALF) = w; }
                }
    }
};
struct EpiRes {
    static constexpr bool PERM = true, CHAIN = false;
    bf16_t* XR;
    __device__ __forceinline__ void operator()(f32x4 (&acc)[2][2][4][2], const Unit& u, int wr, int wc, int fr, int fq) const {
        bf16_t* xb = XR + (size_t)(u.pm * BM + wr * 64) * DM + u.pn * BM;
        const unsigned lo = (unsigned)(fr * DM + wc * 32 + 8 * fq);
        u32x4 xv[2][4][2];
#pragma unroll
        for (int ai = 0; ai < 2; ++ai)
#pragma unroll
            for (int m = 0; m < 4; ++m)
#pragma unroll
                for (int bj = 0; bj < 2; ++bj) xv[ai][m][bj] = *(const u32x4*)(xb + (ai * HALF + m * 16) * DM + bj * HALF + lo);
#pragma unroll
        for (int ai = 0; ai < 2; ++ai)
#pragma unroll
            for (int m = 0; m < 4; ++m)
#pragma unroll
                for (int bj = 0; bj < 2; ++bj) {
                    const u32x4 x = xv[ai][m][bj]; const f32x4 v0 = acc[ai][bj][m][0], v1 = acc[ai][bj][m][1];
                    u32x4 w;
                    w.x = cvt_pk_bf16(bf_lo(x.x) + v0[0], bf_hi(x.x) + v0[1]); w.y = cvt_pk_bf16(bf_lo(x.y) + v0[2], bf_hi(x.y) + v0[3]);
                    w.z = cvt_pk_bf16(bf_lo(x.z) + v1[0], bf_hi(x.z) + v1[1]); w.w = cvt_pk_bf16(bf_lo(x.w) + v1[2], bf_hi(x.w) + v1[3]);
                    *(u32x4*)(xb + (ai * HALF + m * 16) * DM + bj * HALF + lo) = w;
                }
    }
};

template <class Epi, class Sched>
__device__ __forceinline__ void gemm_phase(LAS unsigned char* lds, const Gemm g, const Sched& S, const Epi& E) {
    int tid = threadIdx.x; asm volatile("" : "+v"(tid));
    const int wid = __builtin_amdgcn_readfirstlane(tid >> 6), lane = tid & 63, wr = wid >> 2, wc = wid & 3, fr = lane & 15, fq = lane >> 4;
    const int K = g.K, nt = K / BK;
    unsigned voffA[2], voffB[2];
#pragma unroll
    for (int i = 0; i < 2; ++i) { int R, C; stage_rc(tid * 16 + i * 8192, R, C); const int Rb = Epi::PERM ? ((R & ~31) + perm32(R & 31)) : R;
        voffA[i] = (unsigned)(R * g.lda + C) * 2u; voffB[i] = (unsigned)(Rb * K + C) * 2u; }
    const size_t kstep = (size_t)(BK * 2);
    const size_t hstepA = (size_t)HALF * g.lda * 2, hstepB = (size_t)HALF * K * 2;
    const size_t tstepA = 2 * hstepA, tstepB = 2 * hstepB;
    const unsigned ldsw = (unsigned)wid * 1024u;
    const int aoff = lds_byte(wr * 64 + fr, fq * 8), boff = lds_byte(wc * 32 + fr, fq * 8);
#define PG8_SA(b, h) (((b) * 2 + (h)) * HTB)
#define PG8_SB(b, h) ((4 + (b) * 2 + (h)) * HTB)
#define PG8_STAGE(bufoff, gbase, voff) do { _Pragma("unroll") for (int _i = 0; _i < 2; ++_i) \
        __builtin_amdgcn_global_load_lds((const unsigned*)((const char*)(gbase) + (voff)[_i]), (LAS unsigned*)(lds + (bufoff) + ldsw + _i * 8192), 16, 0, 0); } while (0)
#define PG8_LDA(dst, b, h) do { _Pragma("unroll") for (int m = 0; m < 4; ++m) _Pragma("unroll") for (int k = 0; k < 2; ++k) dst[m][k] = *(const LAS bf16x8*)(lds + PG8_SA(b, h) + aoff + m * 2048 + k * 1024); } while (0)
#define PG8_LDB(dst, b, h) do { _Pragma("unroll") for (int n = 0; n < 2; ++n) _Pragma("unroll") for (int k = 0; k < 2; ++k) dst[n][k] = *(const LAS bf16x8*)(lds + PG8_SB(b, h) + boff + n * 2048 + k * 1024); } while (0)
#define PG8_MMA(ai, bj, At, Bt) do { __builtin_amdgcn_s_setprio(1); _Pragma("unroll") for (int m = 0; m < 4; ++m) _Pragma("unroll") for (int n = 0; n < 2; ++n) _Pragma("unroll") for (int k = 0; k < 2; ++k) \
        acc[ai][bj][m][n] = __builtin_amdgcn_mfma_f32_16x16x32_bf16(Bt[n][k], At[m][k], acc[ai][bj][m][n], 0, 0, 0); __builtin_amdgcn_s_setprio(0); } while (0)
#define PG8_WAIT_V(n) asm volatile("s_waitcnt vmcnt(" #n ")" ::: "memory")
#define PG8_WAIT_L(n) asm volatile("s_waitcnt lgkmcnt(" #n ")" ::: "memory")
#define PG8_BAR __builtin_amdgcn_s_barrier()
#define PG8_SCHED __builtin_amdgcn_sched_barrier(0)
    Unit cur, nxt; int ui = 0;
    if (!S.next(0, cur)) return;
    f32x4 acc[2][2][4][2];
#pragma unroll
    for (int a = 0; a < 2; ++a)
#pragma unroll
        for (int b = 0; b < 2; ++b)
#pragma unroll
            for (int m = 0; m < 4; ++m)
#pragma unroll
                for (int n = 0; n < 2; ++n) acc[a][b][m][n] = (f32x4){0.f, 0.f, 0.f, 0.f};
    bf16x8 At[4][2], B0[2][2], B1[2][2];
    const char* cA = (const char*)g.A + (size_t)cur.b * g.abs * 2 + (size_t)cur.pm * tstepA;
    const char* cB = (const char*)g.Bt + (size_t)cur.b * g.bbs * 2 + (size_t)cur.pn * tstepB;
    PG8_STAGE(PG8_SB(0, 0), cB, voffB); PG8_STAGE(PG8_SB(0, 1), cB + hstepB, voffB); PG8_STAGE(PG8_SA(0, 0), cA, voffA); PG8_STAGE(PG8_SA(0, 1), cA + hstepA, voffA);
    if (wr == 1) PG8_BAR;
    PG8_WAIT_V(2); PG8_BAR;
    PG8_STAGE(PG8_SB(1, 0), cB + kstep, voffB); PG8_STAGE(PG8_SA(1, 0), cA + kstep, voffA); PG8_STAGE(PG8_SB(1, 1), cB + hstepB + kstep, voffB);
    PG8_WAIT_V(6); PG8_BAR;
    for (;;) {
        const bool has_next = S.next(ui + 1, nxt);
        const char* nA = has_next ? (const char*)g.A + (size_t)nxt.b * g.abs * 2 + (size_t)nxt.pm * tstepA : cA;
        const char* nB = has_next ? (const char*)g.Bt + (size_t)nxt.b * g.bbs * 2 + (size_t)nxt.pn * tstepB : cB;
        for (int t = 0; t < nt; t += 2) {
            const bool last = (t == nt - 2);
            const char* a1 = cA + (size_t)(t + 1) * kstep;
            const char* a2 = last ? nA : cA + (size_t)(t + 2) * kstep; const char* b2 = last ? nB : cB + (size_t)(t + 2) * kstep;
            const char* a3 = a2 + kstep; const char* b3 = b2 + kstep;
            PG8_LDB(B0, 0, 0); PG8_LDB(B1, 0, 1); PG8_SCHED; PG8_LDA(At, 0, 0); PG8_STAGE(PG8_SA(1, 1), a1 + hstepA, voffA);
            PG8_WAIT_V(8); PG8_WAIT_L(0); PG8_BAR; PG8_MMA(0, 0, At, B0); PG8_MMA(0, 1, At, B1); PG8_BAR; PG8_SCHED;
            PG8_LDA(At, 0, 1); PG8_STAGE(PG8_SB(0, 0), b2, voffB); PG8_STAGE(PG8_SB(0, 1), b2 + hstepB, voffB); PG8_STAGE(PG8_SA(0, 0), a2, voffA);
            PG8_WAIT_V(8); PG8_WAIT_L(0); PG8_BAR; PG8_MMA(1, 0, At, B0); PG8_MMA(1, 1, At, B1); PG8_BAR; PG8_SCHED;
            PG8_LDB(B0, 1, 0); PG8_LDB(B1, 1, 1); PG8_SCHED; PG8_LDA(At, 1, 0); PG8_STAGE(PG8_SA(0, 1), a2 + hstepA, voffA);
            PG8_WAIT_V(8); PG8_WAIT_L(0); PG8_BAR; PG8_MMA(0, 0, At, B0); PG8_MMA(0, 1, At, B1); PG8_BAR; PG8_SCHED;
            PG8_LDA(At, 1, 1); PG8_STAGE(PG8_SB(1, 0), b3, voffB); PG8_STAGE(PG8_SB(1, 1), b3 + hstepB, voffB); PG8_STAGE(PG8_SA(1, 0), a3, voffA);
            PG8_WAIT_V(8); PG8_WAIT_L(0); PG8_BAR; PG8_MMA(1, 0, At, B0); PG8_MMA(1, 1, At, B1); PG8_BAR; PG8_SCHED;
        }
        if (wr == 0) PG8_BAR;
        E(acc, cur, wr, wc, fr, fq);
        if (!has_next) break;
        if (!(Epi::CHAIN && nxt.b != 0)) {
#pragma unroll
        for (int a = 0; a < 2; ++a)
#pragma unroll
            for (int b = 0; b < 2; ++b)
#pragma unroll
                for (int m = 0; m < 4; ++m)
#pragma unroll
                    for (int n = 0; n < 2; ++n) acc[a][b][m][n] = (f32x4){0.f, 0.f, 0.f, 0.f};
        }
        cur = nxt; cA = nA; cB = nB; ++ui;
        if (wr == 1) PG8_BAR;
    }
    PG8_WAIT_V(0);
    PG8_BAR;
#undef PG8_SA
#undef PG8_SB
#undef PG8_STAGE
#undef PG8_LDA
#undef PG8_LDB
#undef PG8_MMA
#undef PG8_WAIT_V
#undef PG8_WAIT_L
#undef PG8_BAR
#undef PG8_SCHED
}
}


#define XB_TMO      128
#define XB_XCNT(j)  (256  + 64 * (j))
#define XB_XSUB(j)  (1280 + 64 * (j))
#define XB_XGEN(j)  (2304 + 64 * (j))
#define XB_TOP      3328
#define XB_TOPGEN   3392
#define XCD_BAR_WORDS 3456
#define XB_SPIN_CAP (1u << 18)
__device__ __forceinline__ unsigned xb_ld(unsigned* p)              { return __hip_atomic_load(p, __ATOMIC_RELAXED, __HIP_MEMORY_SCOPE_AGENT); }
__device__ __forceinline__ unsigned xb_add(unsigned* p, unsigned v) { return __hip_atomic_fetch_add(p, v, __ATOMIC_RELAXED, __HIP_MEMORY_SCOPE_AGENT); }
__device__ __forceinline__ unsigned xb_xcc_id() { return (unsigned)__builtin_amdgcn_s_getreg((3 << 11) | 20) & 0xFu; }
#define XB_SPIN(cond, bar) do { unsigned _sp = 0; while (cond) { __builtin_amdgcn_s_sleep(1); \
    if ((++_sp & 255u) == 0u) { if (xb_ld(&(bar)[XB_TMO])) break; if (_sp > XB_SPIN_CAP) { atomicAdd(&(bar)[XB_TMO], 1u); break; } } } } while (0)
struct XcdBarrier { unsigned* bar; unsigned x; volatile LAS unsigned* st; };
__device__ __forceinline__ XcdBarrier xcd_barrier_post(unsigned* bar, volatile LAS unsigned* st) {
    XcdBarrier b; b.bar = bar; b.x = xb_xcc_id(); b.st = st;
    if (threadIdx.x == 0) (void)xb_add(&bar[XB_XCNT(b.x)], 1u);
    return b;
}
__device__ __forceinline__ void xcd_barrier_complete(unsigned* bar, unsigned x, unsigned& nloc, unsigned& nx) {
    const unsigned G = gridDim.x * gridDim.y * gridDim.z;
    unsigned sum, cnt, mine, sp = 0u;
    for (;;) {
        sum = 0u; cnt = 0u; mine = 0u;
#pragma unroll
        for (unsigned j = 0; j < 16; ++j) { const unsigned c = xb_ld(&bar[XB_XCNT(j)]); sum += c; cnt += (c > 0u) ? 1u : 0u; mine = (j == x) ? c : mine; }
        if (sum == G) break;
        __builtin_amdgcn_s_sleep(1);
        if ((++sp & 255u) == 0u) { if (xb_ld(&bar[XB_TMO])) break; if (sp > XB_SPIN_CAP) { atomicAdd(&bar[XB_TMO], 1u); break; } }
    }
    nloc = mine > 0u ? mine : 1u; nx = cnt > 0u ? cnt : 1u;
}
__device__ __forceinline__ void xcd_barrier(const XcdBarrier& b) {
    asm volatile("s_waitcnt vmcnt(0)" ::: "memory");
    __syncthreads();
    if (threadIdx.x == 0) {
        unsigned* bar = b.bar;
        __builtin_amdgcn_s_waitcnt(0);
        unsigned nloc = b.st[0], nx = b.st[1];
        if (nloc == 0u) { xcd_barrier_complete(bar, b.x, nloc, nx); b.st[0] = nloc; b.st[1] = nx; }
        const unsigned old = xb_add(&bar[XB_XSUB(b.x)], 1u);
        const unsigned gen = old / nloc;
        if (old + 1u == (gen + 1u) * nloc) {
            __builtin_amdgcn_fence(__ATOMIC_RELEASE, "agent");
            asm volatile("s_waitcnt vmcnt(0)" ::: "memory");
            const unsigned og = xb_add(&bar[XB_TOP], 1u);
            const unsigned tg = og / nx;
            if (og + 1u == (tg + 1u) * nx) xb_add(&bar[XB_TOPGEN], 1u);
            else XB_SPIN(xb_ld(&bar[XB_TOPGEN]) == tg, bar);
            __builtin_amdgcn_fence(__ATOMIC_ACQUIRE, "agent");
            xb_add(&bar[XB_XGEN(b.x)], 1u);
            asm volatile("s_waitcnt vmcnt(0)" ::: "memory");
        } else {
            XB_SPIN(xb_ld(&bar[XB_XGEN(b.x)]) == gen, bar);
            __builtin_amdgcn_fence(__ATOMIC_ACQUIRE, "agent");
            asm volatile("s_waitcnt vmcnt(0)" ::: "memory");
        }
    }
    __syncthreads();
}

struct Args { const float* in[17]; float* out; unsigned char* ws; int ph_lo, ph_hi; };
enum { I_X = 0, I_NORMG, I_WIN, I_LNG, I_LNB, I_SGW, I_SGB, I_POOLW, I_POOLB, I_POOLS, I_CONVW, I_CONVB, I_WA, I_WB, I_WC, I_WOUT, I_FINALG };

__device__ __forceinline__ int map_col(int n) {
    const int sg = n >> 10, j = n & 1023, pj = (j >> 7) * 256 + (j & 127);
    int st;
    switch (sg) {
        case 0: return pj;
        case 2: return pj + 128;
        case 1: return 2048 + j;
        case 3: return 3072 + j;
        case 5: return 4096 + pj;
        case 7: return 4096 + pj + 128;
        case 6: return 6144 + pj;
        case 8: return 6144 + pj + 128;
        case 9: st = 0; break;
        case 10: st = 1; break;
        case 11: st = 2; break;
        default: st = 3; break;
    }
    const int q = j >> 6, r = j & 63, wc = r >> 4, fq = (r >> 2) & 3, jj = r & 3;
    return 8192 + 256 * q + 128 * (st >> 1) + 32 * wc + 8 * fq + 4 * (st & 1) + jj;
}
struct TItem { const float* W; bf16_t* WT; int K, N, r, map; };
__device__ __forceinline__ void titem_load(const TItem& t, int lane, f32x4 (&tv)[8]) {
    const int nblk = t.N / 32, kb = t.r / nblk, nb = t.r - kb * nblk;
    const float* p = t.W + (size_t)(64 * kb + (lane >> 3)) * t.N + 32 * nb + 4 * (lane & 7);
#pragma unroll
    for (int i = 0; i < 8; ++i) tv[i] = *(const f32x4*)(p + (size_t)(8 * i) * t.N);
}
__device__ __forceinline__ void titem_store(const TItem& t, int lane, const f32x4 (&tv)[8], LAS float* scr) {
    const int nblk = t.N / 32, kb = t.r / nblk, nb = t.r - kb * nblk, k0 = 64 * kb, n0 = 32 * nb;
#pragma unroll
    for (int i = 0; i < 8; ++i) { LAS float* d = scr + (8 * i + (lane >> 3)) * 33 + 4 * (lane & 7); d[0] = tv[i].x; d[1] = tv[i].y; d[2] = tv[i].z; d[3] = tv[i].w; }
    LDS_WAIT(); asm volatile("" ::: "memory");
    const int c = lane & 7;
#pragma unroll
    for (int j = 0; j < 4; ++j) { const int n = (lane >> 3) + 8 * j; const LAS float* sp = scr + (8 * c) * 33 + n;
        u32x4 o; o.x = cvt_pk_bf16(sp[0 * 33], sp[1 * 33]); o.y = cvt_pk_bf16(sp[2 * 33], sp[3 * 33]); o.z = cvt_pk_bf16(sp[4 * 33], sp[5 * 33]); o.w = cvt_pk_bf16(sp[6 * 33], sp[7 * 33]);
        const int row = t.map ? map_col(n0 + n) : n0 + n;
        *(u32x4*)(t.WT + (size_t)row * t.K + k0 + 8 * c) = o; }
    LDS_WAIT(); asm volatile("" ::: "memory");
}

template <bool OUT_BF16>
__device__ __forceinline__ void rms_rows(const float* X, const float* gvec, void* out, int gw, int NGW, int lane, bf16_t* xcopy = nullptr) {
    f32x4 gv[4];
#pragma unroll
    for (int j = 0; j < 4; ++j) gv[j] = *((const f32x4*)gvec + lane + 64 * j);
    for (int m0 = gw; m0 < MTOK; m0 += 4 * NGW) {
        f32x4 v[4][4]; float s[4];
#pragma unroll
        for (int q = 0; q < 4; ++q) { const int m = m0 + q * NGW; const f32x4* xr = (const f32x4*)(X + (size_t)(m < MTOK ? m : m0) * DM) + lane;
#pragma unroll
            for (int j = 0; j < 4; ++j) v[q][j] = xr[64 * j]; }
#pragma unroll
        for (int q = 0; q < 4; ++q) { float t = 0.f;
#pragma unroll
            for (int j = 0; j < 4; ++j) t += (v[q][j].x * v[q][j].x + v[q][j].y * v[q][j].y) + (v[q][j].z * v[q][j].z + v[q][j].w * v[q][j].w);
            s[q] = t; }
#pragma unroll
        for (int o = 1; o < 64; o <<= 1)
#pragma unroll
            for (int q = 0; q < 4; ++q) s[q] += __shfl_xor(s[q], o);
#pragma unroll
        for (int q = 0; q < 4; ++q) {
            const int m = m0 + q * NGW; if (m >= MTOK) break;
            const float r = 1.0f / sqrtf(s[q] * (1.f / DM) + RMS_EPS);
            if (xcopy) { u32x2* oc = (u32x2*)(xcopy + (size_t)m * DM) + lane;
#pragma unroll
                for (int j = 0; j < 4; ++j) { u32x2 w; w.x = cvt_pk_bf16(v[q][j].x, v[q][j].y); w.y = cvt_pk_bf16(v[q][j].z, v[q][j].w); oc[64 * j] = w; } }
            if (OUT_BF16) {
                u32x2* o = (u32x2*)((bf16_t*)out + (size_t)m * DM) + lane;
#pragma unroll
                for (int j = 0; j < 4; ++j) { u32x2 w; w.x = cvt_pk_bf16(v[q][j].x * r * gv[j].x, v[q][j].y * r * gv[j].y); w.y = cvt_pk_bf16(v[q][j].z * r * gv[j].z, v[q][j].w * r * gv[j].w); o[64 * j] = w; }
            } else {
                f32x4* o = (f32x4*)((float*)out + (size_t)m * DM) + lane;
#pragma unroll
                for (int j = 0; j < 4; ++j) o[64 * j] = v[q][j] * r * gv[j];
            }
        }
    }
}

template <bool OUT_BF16>
__device__ __forceinline__ void rms_rows_xr(const bf16_t* X, const float* gvec, void* out, int gw, int NGW, int lane) {
    f32x4 gv[2][2];
#pragma unroll
    for (int j = 0; j < 2; ++j) { gv[j][0] = *(const f32x4*)(gvec + lane * 8 + 512 * j); gv[j][1] = *(const f32x4*)(gvec + lane * 8 + 512 * j + 4); }
    for (int m0 = gw; m0 < MTOK; m0 += 4 * NGW) {
        u32x4 q[4][2]; float s[4];
#pragma unroll
        for (int r = 0; r < 4; ++r) { const int m = m0 + r * NGW; const bf16_t* xr = X + (size_t)(m < MTOK ? m : m0) * DM + lane * 8;
            q[r][0] = *(const u32x4*)xr; q[r][1] = *(const u32x4*)(xr + 512); }
        float v[4][2][8];
#pragma unroll
        for (int r = 0; r < 4; ++r) { float t = 0.f;
#pragma unroll
            for (int j = 0; j < 2; ++j) { const u32x4 z = q[r][j];
                v[r][j][0] = bf_lo(z.x); v[r][j][1] = bf_hi(z.x); v[r][j][2] = bf_lo(z.y); v[r][j][3] = bf_hi(z.y); v[r][j][4] = bf_lo(z.z); v[r][j][5] = bf_hi(z.z); v[r][j][6] = bf_lo(z.w); v[r][j][7] = bf_hi(z.w);
#pragma unroll
                for (int e = 0; e < 8; ++e) t += v[r][j][e] * v[r][j][e]; }
            s[r] = t; }
#pragma unroll
        for (int o = 1; o < 64; o <<= 1)
#pragma unroll
            for (int r = 0; r < 4; ++r) s[r] += __shfl_xor(s[r], o);
#pragma unroll
        for (int r = 0; r < 4; ++r) {
            const int m = m0 + r * NGW; if (m >= MTOK) break;
            const float rs = 1.0f / sqrtf(s[r] * (1.f / DM) + RMS_EPS);
#pragma unroll
            for (int j = 0; j < 2; ++j) {
                float y[8];
#pragma unroll
                for (int e = 0; e < 8; ++e) y[e] = v[r][j][e] * rs * gv[j][e >> 2][e & 3];
                if (OUT_BF16) { u32x4 w; w.x = cvt_pk_bf16(y[0], y[1]); w.y = cvt_pk_bf16(y[2], y[3]); w.z = cvt_pk_bf16(y[4], y[5]); w.w = cvt_pk_bf16(y[6], y[7]);
                    *(u32x4*)((bf16_t*)out + (size_t)m * DM + lane * 8 + 512 * j) = w; }
                else { float* o = (float*)out + (size_t)m * DM + lane * 8 + 512 * j;
                    __builtin_nontemporal_store((f32x4){y[0], y[1], y[2], y[3]}, (f32x4*)o); __builtin_nontemporal_store((f32x4){y[4], y[5], y[6], y[7]}, (f32x4*)(o + 4)); }
            }
        }
    }
}

__device__ __forceinline__ void phase_p0(const Args& a, LAS unsigned char* lds, int l) {
    int tid = threadIdx.x; asm volatile("" : "+v"(tid));
    const int lane = tid & 63, wave = __builtin_amdgcn_readfirstlane(tid >> 6);
    const int G = gridDim.x, gw = blockIdx.x * NWAVES + wave, NGW = G * NWAVES;
    LAS float* scr = (LAS float*)(lds + wave * 16384);
    bf16_t* WIN = (bf16_t*)(a.ws + WS_WIN); bf16_t* WABC = (bf16_t*)(a.ws + WS_WABC); bf16_t* WOUT = (bf16_t*)(a.ws + WS_WOUT);
    bf16_t* POOL = (bf16_t*)(a.ws + WS_POOL); bf16_t* SGW = (bf16_t*)(a.ws + WS_SGW);
    constexpr int IT_IN = (DM / 64) * (NIN / 32), IT_SQ = (DM / 64) * (DM / 32);
    constexpr int NITEMS = IT_IN + 4 * IT_SQ;
#define P0_DECODE(T, IT) do { int r_ = (IT); \
        if (r_ < IT_IN) { T = TItem{a.in[I_WIN] + (size_t)l * DM * NIN, WIN, DM, NIN, r_, 1}; } \
        else if ((r_ -= IT_IN) < IT_SQ) { T = TItem{a.in[I_WA] + (size_t)l * DM * DM, WABC, DM, DM, r_, 0}; } \
        else if ((r_ -= IT_SQ) < IT_SQ) { T = TItem{a.in[I_WB] + (size_t)l * DM * DM, WABC + (size_t)DM * DM, DM, DM, r_, 0}; } \
        else if ((r_ -= IT_SQ) < IT_SQ) { T = TItem{a.in[I_WC] + (size_t)l * DM * DM, WABC + (size_t)2 * DM * DM, DM, DM, r_, 0}; } \
        else { r_ -= IT_SQ; T = TItem{a.in[I_WOUT] + (size_t)l * DM * DM, WOUT, DM, DM, r_, 0}; } } while (0)
    {
        int it = gw;
        TItem cur{}, nxt{}; f32x4 tva[8], tvb[8];
        if (it < NITEMS) { P0_DECODE(cur, it); titem_load(cur, lane, tva); }
        while (it < NITEMS) {
            const int nx = it + NGW;
            if (nx < NITEMS) { P0_DECODE(nxt, nx); titem_load(nxt, lane, tvb); }
            titem_store(cur, lane, tva, scr);
#pragma unroll
            for (int i = 0; i < 8; ++i) tva[i] = tvb[i];
            cur = nxt; it = nx;
        }
    }
#undef P0_DECODE
    for (int e = blockIdx.x * NTHREADS + tid; e < 4 * 256 * 64; e += G * NTHREADS) {
        const int d = e & 255, c4 = (e >> 8) & 63, pg = e >> 14;
        const float* src = a.in[I_POOLW] + (size_t)(l * 4 + pg) * 65536 + (size_t)(4 * c4) * 256 + d;
        u32x2 o; o.x = cvt_pk_bf16(src[0], src[256]); o.y = cvt_pk_bf16(src[512], src[768]);
        *(u32x2*)(POOL + (size_t)pg * 65536 + (size_t)d * 256 + 4 * c4) = o;
    }
    for (int e = blockIdx.x * NTHREADS + tid; e < 8 * 128 * 128 / 4; e += G * NTHREADS) {
        const f32x4 w = *((const f32x4*)(a.in[I_SGW] + (size_t)l * 8 * 128 * 128) + e);
        const int idx = e * 4, i = (idx >> 7) & 127, j = idx & 127;
        const bool keep = (j >> 6) <= (i >> 6);
        u32x2 o; o.x = keep ? cvt_pk_bf16(w.x, w.y) : 0u; o.y = keep ? cvt_pk_bf16(w.z, w.w) : 0u;
        *((u32x2*)SGW + e) = o;
    }
    if (l == 0) rms_rows<true>(a.in[I_X], a.in[I_NORMG], a.ws + WS_H, gw, NGW, lane, (bf16_t*)(a.ws + WS_XR));
    else rms_rows_xr<true>((const bf16_t*)(a.ws + WS_XR), a.in[I_NORMG] + (size_t)l * DM, a.ws + WS_H, gw, NGW, lane);
}

__device__ __forceinline__ void mixer_a(const Args& a, LAS unsigned char* lds, bf16_t* P, int l, int nb) {
    int tid = threadIdx.x; asm volatile("" : "+v"(tid));
    const int lane = tid & 63, wave = __builtin_amdgcn_readfirstlane(tid >> 6), fr = lane & 15, fq = lane >> 4;
    LAS f32x2* stat = (LAS f32x2*)lds;
    constexpr int VS = 132, VBUF = 128 * VS;
    constexpr int WSS = 136, WBUF = 128 * WSS;
    LAS bf16_t* vn0 = (LAS bf16_t*)(lds + 1024);
    LAS bf16_t* wsm0 = (LAS bf16_t*)(lds + 1024 + 2 * VBUF * 2);
    const size_t r0 = (size_t)nb * 128;
    const bf16_t* SGW = (const bf16_t*)(a.ws + WS_SGW);
    const int cc = tid & 15, jr = tid >> 4;
    u32x4 raw[4], wreg[4]; f32x4 lnp[4]; u32x4 az_n[4]; float bias_n[4];
    const int blk = wave & 3, hrow = wave >> 2;
#define ITL(i4) ((((i4) >> 1) << 2) + ((i4) & 1))
    const bf16_t* Pgv = P + r0 * LDP + S_GV; bf16_t* Pya = P + r0 * LDP + S_YA;
    const float* lngb = a.in[I_LNG] + (size_t)l * 1024; const float* lnbb = a.in[I_LNB] + (size_t)l * 1024; const float* sgbb = a.in[I_SGB] + (size_t)l * 1024;
    const unsigned o_raw = (unsigned)(jr * LDP + cc * 8), o_w = (unsigned)(jr * 128 + cc * 8), o_az = (unsigned)(fr * LDP + blk * 32 + fq * 8);
#define MA_PREFETCH(G) do { \
        const bf16_t* pg_ = Pgv + (G) * 128; const bf16_t* wg_ = SGW + (size_t)(G) * 16384; const bf16_t* pa_ = Pya + (G) * 128 + hrow * 32 * LDP; \
        _Pragma("unroll") for (int i_ = 0; i_ < 4; ++i_) { raw[i_] = *(const u32x4*)(pg_ + i_ * 32 * LDP + o_raw); wreg[i_] = *(const u32x4*)(wg_ + i_ * 32 * 128 + o_w); } \
        { const float* lg_ = lngb + (G) * 128; const float* lb_ = lnbb + (G) * 128; \
          lnp[0] = *(const f32x4*)(lg_ + cc * 8); lnp[1] = *(const f32x4*)(lg_ + cc * 8 + 4); lnp[2] = *(const f32x4*)(lb_ + cc * 8); lnp[3] = *(const f32x4*)(lb_ + cc * 8 + 4); } \
        _Pragma("unroll") for (int i4_ = 0; i4_ < 4; ++i4_) { \
            az_n[i4_] = *(const u32x4*)(pa_ + ITL(i4_) * 16 * LDP + o_az); \
            bias_n[i4_] = sgbb[(G) * 128 + hrow * 32 + ITL(i4_) * 16 + fr]; } } while (0)
    MA_PREFETCH(0);
    u32x4 qa[2][8][2];
#pragma unroll
    for (int h = 0; h < 2; ++h)
#pragma unroll
        for (int jj = 0; jj < 8; ++jj) { const bf16_t* rp = Pgv + (wave * 16 + h * 8 + jj) * LDP; qa[h][jj][0] = *(const u32x4*)(rp + lane * 8); qa[h][jj][1] = *(const u32x4*)(rp + 512 + lane * 8); }
#pragma unroll
    for (int h = 0; h < 2; ++h) {
        u32x4 (&qq)[8][2] = qa[h];
        float sm[8];
#pragma unroll
        for (int jj = 0; jj < 8; ++jj) { float t = 0.f;
#pragma unroll
            for (int w = 0; w < 2; ++w) { const u32x4 z = qq[jj][w]; t += (bf_lo(z.x) + bf_hi(z.x)) + (bf_lo(z.y) + bf_hi(z.y)) + (bf_lo(z.z) + bf_hi(z.z)) + (bf_lo(z.w) + bf_hi(z.w)); }
            sm[jj] = t; }
#pragma unroll
        for (int o = 1; o < 64; o <<= 1)
#pragma unroll
            for (int jj = 0; jj < 8; ++jj) sm[jj] += __shfl_xor(sm[jj], o);
        float s2[8];
#pragma unroll
        for (int jj = 0; jj < 8; ++jj) { const float mean = sm[jj] * (1.f / 1024.f); sm[jj] = mean; float t = 0.f;
#pragma unroll
            for (int w = 0; w < 2; ++w) { const u32x4 z = qq[jj][w]; float d;
                d = bf_lo(z.x) - mean; t += d * d; d = bf_hi(z.x) - mean; t += d * d; d = bf_lo(z.y) - mean; t += d * d; d = bf_hi(z.y) - mean; t += d * d;
                d = bf_lo(z.z) - mean; t += d * d; d = bf_hi(z.z) - mean; t += d * d; d = bf_lo(z.w) - mean; t += d * d; d = bf_hi(z.w) - mean; t += d * d; }
            s2[jj] = t; }
#pragma unroll
        for (int o = 1; o < 64; o <<= 1)
#pragma unroll
            for (int jj = 0; jj < 8; ++jj) s2[jj] += __shfl_xor(s2[jj], o);
#pragma unroll
        for (int jj = 0; jj < 8; ++jj) if (lane == jj) stat[wave * 16 + h * 8 + jj] = (f32x2){sm[jj], 1.0f / sqrtf(s2[jj] * (1.f / 1024.f) + LN_EPS)};
    }
    __syncthreads();
#pragma unroll 1
    for (int g = 0; g < 8; ++g) {
        LAS bf16_t* vn = vn0 + (g & 1) * VBUF;
        LAS bf16_t* wsm = wsm0 + (g & 1) * WBUF;
        {
            const f32x4 g0 = lnp[0], g1 = lnp[1], b0 = lnp[2], b1 = lnp[3];
#pragma unroll
            for (int i = 0; i < 4; ++i) {
                const int j = jr + 32 * i; const u32x4 q = raw[i]; const f32x2 st = stat[j];
                float y[8];
                y[0] = (bf_lo(q.x) - st.x) * st.y * g0.x + b0.x; y[1] = (bf_hi(q.x) - st.x) * st.y * g0.y + b0.y;
                y[2] = (bf_lo(q.y) - st.x) * st.y * g0.z + b0.z; y[3] = (bf_hi(q.y) - st.x) * st.y * g0.w + b0.w;
                y[4] = (bf_lo(q.z) - st.x) * st.y * g1.x + b1.x; y[5] = (bf_hi(q.z) - st.x) * st.y * g1.y + b1.y;
                y[6] = (bf_lo(q.w) - st.x) * st.y * g1.z + b1.z; y[7] = (bf_hi(q.w) - st.x) * st.y * g1.w + b1.w;
                u32x2 w0, w1; w0.x = cvt_pk_bf16(y[0], y[1]); w0.y = cvt_pk_bf16(y[2], y[3]); w1.x = cvt_pk_bf16(y[4], y[5]); w1.y = cvt_pk_bf16(y[6], y[7]);
                *(LAS u32x2*)(vn + j * VS + 32 * (cc >> 2) + 4 * (cc & 3)) = w0; *(LAS u32x2*)(vn + j * VS + 32 * (cc >> 2) + 16 + 4 * (cc & 3)) = w1;
                *(LAS u32x4*)(wsm + j * WSS + cc * 8) = wreg[i];
            }
        }
        u32x4 az_c[4]; float bias_c[4];
#pragma unroll
        for (int i4 = 0; i4 < 4; ++i4) { az_c[i4] = az_n[i4]; bias_c[i4] = bias_n[i4]; }
        if (g < 7) MA_PREFETCH(g + 1);
        __syncthreads();
        bf16x8 vf[2][4];
        {
            const unsigned tra = (unsigned)(size_t)vn + (unsigned)(((fq * 8 + (fr >> 2)) * VS + blk * 32 + 4 * (fr & 3)) * 2);
            s16x4 t0, t1, t2, t3, t4, t5, t6, t7, u0, u1, u2, u3, u4, u5, u6, u7;
            asm volatile("ds_read_b64_tr_b16 %0, %16\n\t"
                         "ds_read_b64_tr_b16 %1, %16 offset:1056\n\t"
                         "ds_read_b64_tr_b16 %2, %16 offset:8448\n\t"
                         "ds_read_b64_tr_b16 %3, %16 offset:9504\n\t"
                         "ds_read_b64_tr_b16 %4, %16 offset:16896\n\t"
                         "ds_read_b64_tr_b16 %5, %16 offset:17952\n\t"
                         "ds_read_b64_tr_b16 %6, %16 offset:25344\n\t"
                         "ds_read_b64_tr_b16 %7, %16 offset:26400\n\t"
                         "ds_read_b64_tr_b16 %8, %16 offset:32\n\t"
                         "ds_read_b64_tr_b16 %9, %16 offset:1088\n\t"
                         "ds_read_b64_tr_b16 %10, %16 offset:8480\n\t"
                         "ds_read_b64_tr_b16 %11, %16 offset:9536\n\t"
                         "ds_read_b64_tr_b16 %12, %16 offset:16928\n\t"
                         "ds_read_b64_tr_b16 %13, %16 offset:17984\n\t"
                         "ds_read_b64_tr_b16 %14, %16 offset:25376\n\t"
                         "ds_read_b64_tr_b16 %15, %16 offset:26432\n\t"
                         "s_waitcnt lgkmcnt(0)"
                         : "=&v"(t0), "=&v"(t1), "=&v"(t2), "=&v"(t3), "=&v"(t4), "=&v"(t5), "=&v"(t6), "=&v"(t7),
                           "=&v"(u0), "=&v"(u1), "=&v"(u2), "=&v"(u3), "=&v"(u4), "=&v"(u5), "=&v"(u6), "=&v"(u7) : "v"(tra) : "memory");
            vf[0][0] = __builtin_shufflevector(t0, t1, 0, 1, 2, 3, 4, 5, 6, 7); vf[0][1] = __builtin_shufflevector(t2, t3, 0, 1, 2, 3, 4, 5, 6, 7);
            vf[0][2] = __builtin_shufflevector(t4, t5, 0, 1, 2, 3, 4, 5, 6, 7); vf[0][3] = __builtin_shufflevector(t6, t7, 0, 1, 2, 3, 4, 5, 6, 7);
            vf[1][0] = __builtin_shufflevector(u0, u1, 0, 1, 2, 3, 4, 5, 6, 7); vf[1][1] = __builtin_shufflevector(u2, u3, 0, 1, 2, 3, 4, 5, 6, 7);
            vf[1][2] = __builtin_shufflevector(u4, u5, 0, 1, 2, 3, 4, 5, 6, 7); vf[1][3] = __builtin_shufflevector(u6, u7, 0, 1, 2, 3, 4, 5, 6, 7);
        }
        f32x4 acc[4][2];
#pragma unroll
        for (int i4 = 0; i4 < 4; ++i4) { acc[i4][0] = (f32x4){0.f, 0.f, 0.f, 0.f}; acc[i4][1] = (f32x4){0.f, 0.f, 0.f, 0.f}; }
        const LAS bf16_t* wl = wsm + (hrow * 32 + fr) * WSS + fq * 8;
#pragma unroll
        for (int i4 = 0; i4 < 4; ++i4)
#pragma unroll
            for (int k = 0; k < 4; ++k) {
                if (i4 < 2 && k >= 2) continue;
                const bf16x8 wf = *(const LAS bf16x8*)(wl + ITL(i4) * 16 * WSS + k * 32);
                acc[i4][0] = __builtin_amdgcn_mfma_f32_16x16x32_bf16(vf[0][k], wf, acc[i4][0], 0, 0, 0);
                acc[i4][1] = __builtin_amdgcn_mfma_f32_16x16x32_bf16(vf[1][k], wf, acc[i4][1], 0, 0, 0);
            }
#pragma unroll
        for (int i4 = 0; i4 < 4; ++i4) {
            const u32x4 z = az_c[i4]; const float bs = bias_c[i4];
            u32x4 w;
            w.x = cvt_pk_bf16((acc[i4][0][0] + bs) * bf_lo(z.x), (acc[i4][0][1] + bs) * bf_hi(z.x));
            w.y = cvt_pk_bf16((acc[i4][0][2] + bs) * bf_lo(z.y), (acc[i4][0][3] + bs) * bf_hi(z.y));
            w.z = cvt_pk_bf16((acc[i4][1][0] + bs) * bf_lo(z.z), (acc[i4][1][1] + bs) * bf_hi(z.z));
            w.w = cvt_pk_bf16((acc[i4][1][2] + bs) * bf_lo(z.w), (acc[i4][1][3] + bs) * bf_hi(z.w));
            *(u32x4*)(Pya + g * 128 + (hrow * 32 + ITL(i4) * 16) * LDP + o_az) = w;
        }
    }
#undef MA_PREFETCH
#undef ITL
    __syncthreads();
}

template <int GI> struct PoolCfg { static constexpr int WIN = 2 << GI, NV = WIN + 7; };
template <int GI>
__device__ __forceinline__ void pool_load(const bf16_t* P, size_t r0, int pos0, int tid, u32x4 (&v)[PoolCfg<GI>::NV]) {
    constexpr int WIN = PoolCfg<GI>::WIN, NV = PoolCfg<GI>::NV;
    const int tseg = tid >> 5, cch = tid & 31;
    const int p_first = pos0 + tseg * 8 - (WIN - 1);
    const bf16_t* base = P + r0 * LDP + S_BP + GI * 256;
    const unsigned off = (unsigned)(tseg * 8 * LDP + cch * 8);
#pragma unroll
    for (int i = 0; i < NV; ++i) {
        if (p_first + i >= 0) v[i] = *(const u32x4*)(base + (long)(i - (WIN - 1)) * LDP + off);
        else v[i] = (u32x4){0u, 0u, 0u, 0u};
    }
}
template <int GI>
__device__ __forceinline__ void pool_compute(const u32x4 (&v)[PoolCfg<GI>::NV], LAS bf16_t* dt, int pos0, int tid) {
    constexpr int WIN = PoolCfg<GI>::WIN, DS = 264;
    const int tseg = tid >> 5, cch = tid & 31;
    float inv[8];
#pragma unroll
    for (int t = 0; t < 8; ++t) { const int sp = pos0 + tseg * 8 + t; inv[t] = 1.0f / (float)((sp + 1 < WIN) ? (sp + 1) : WIN); }
    u32x4 o[8];
#pragma unroll
    for (int w = 0; w < 4; ++w) {
        float rl = 0.f, rh = 0.f;
#pragma unroll
        for (int i = 0; i < WIN - 1; ++i) { rl += bf_lo(v[i][w]); rh += bf_hi(v[i][w]); }
#pragma unroll
        for (int t = 0; t < 8; ++t) {
            const float pl = bf_lo(v[WIN - 1 + t][w]), ph = bf_hi(v[WIN - 1 + t][w]);
            rl += pl; rh += ph;
            o[t][w] = cvt_pk_bf16(rl * inv[t] - pl, rh * inv[t] - ph);
            rl -= bf_lo(v[t][w]); rh -= bf_hi(v[t][w]);
        }
    }
#pragma unroll
    for (int t = 0; t < 8; ++t) *(LAS u32x4*)(dt + (tseg * 8 + t) * DS + cch * 8) = o[t];
}

template <int GI, int NVN>
__device__ __forceinline__ void bc_group(const Args& a, LAS bf16_t* dt, bf16_t* P, int l, size_t r0, int pos0, int tid, const u32x4 (&v_cur)[PoolCfg<GI>::NV], u32x4 (&v_nxt)[NVN]) {
    constexpr int DS = 264, g = GI;
    const int lane = tid & 63, wave = __builtin_amdgcn_readfirstlane(tid >> 6), fr = lane & 15, fq = lane >> 4;
    const bf16_t* pw = (const bf16_t*)(a.ws + WS_POOL) + (size_t)g * 65536 + wave * 32 * 256;
    const unsigned o_w = (unsigned)((8 * (fr >> 2) + (fr & 3)) * 256 + fq * 8);
    bf16x8 bfr[2][8];
#pragma unroll
    for (int n = 0; n < 2; ++n)
#pragma unroll
        for (int k = 0; k < 8; ++k) bfr[n][k] = *(const bf16x8*)(pw + n * 4 * 256 + k * 32 + o_w);
    pool_compute<GI>(v_cur, dt, pos0, tid);
    bf16_t* pz = P + r0 * LDP + S_BZ + g * 256 + wave * 32;
    const unsigned o_z = (unsigned)(fr * LDP + fq * 8);
    u32x4 z[8];
#pragma unroll
    for (int mt = 0; mt < 8; ++mt) z[mt] = *(const u32x4*)(pz + mt * 16 * LDP + o_z);
    __syncthreads();
    f32x4 acc[8][2];
#pragma unroll
    for (int mt = 0; mt < 8; ++mt) { acc[mt][0] = (f32x4){0.f, 0.f, 0.f, 0.f}; acc[mt][1] = (f32x4){0.f, 0.f, 0.f, 0.f}; }
#pragma unroll
    for (int mt = 0; mt < 8; ++mt)
#pragma unroll
        for (int k = 0; k < 8; ++k) {
            const bf16x8 af = *(const LAS bf16x8*)(dt + (mt * 16 + fr) * DS + k * 32 + fq * 8);
            acc[mt][0] = __builtin_amdgcn_mfma_f32_16x16x32_bf16(bfr[0][k], af, acc[mt][0], 0, 0, 0);
            acc[mt][1] = __builtin_amdgcn_mfma_f32_16x16x32_bf16(bfr[1][k], af, acc[mt][1], 0, 0, 0);
        }
    if constexpr (GI < 3) pool_load<GI + 1>(P, r0, pos0, tid, v_nxt);
    {
        const int c = g * 256 + wave * 32 + 8 * fq;
        const float* pbp = a.in[I_POOLB] + (size_t)l * 1024 + c; const float* psp = a.in[I_POOLS] + (size_t)l * 1024 + c;
        const f32x4 pb0 = *(const f32x4*)pbp, pb1 = *(const f32x4*)(pbp + 4), ps0 = *(const f32x4*)psp, ps1 = *(const f32x4*)(psp + 4);
#pragma unroll
        for (int mt = 0; mt < 8; ++mt) {
            const u32x4 zz = z[mt];
            u32x4 w;
            w.x = cvt_pk_bf16((acc[mt][0][0] + pb0.x) * ps0.x * bf_lo(zz.x), (acc[mt][0][1] + pb0.y) * ps0.y * bf_hi(zz.x));
            w.y = cvt_pk_bf16((acc[mt][0][2] + pb0.z) * ps0.z * bf_lo(zz.y), (acc[mt][0][3] + pb0.w) * ps0.w * bf_hi(zz.y));
            w.z = cvt_pk_bf16((acc[mt][1][0] + pb1.x) * ps1.x * bf_lo(zz.z), (acc[mt][1][1] + pb1.y) * ps1.y * bf_hi(zz.z));
            w.w = cvt_pk_bf16((acc[mt][1][2] + pb1.z) * ps1.z * bf_lo(zz.w), (acc[mt][1][3] + pb1.w) * ps1.w * bf_hi(zz.w));
            *(u32x4*)(pz + mt * 16 * LDP + o_z) = w;
        }
    }
    __syncthreads();
}

__device__ __forceinline__ void mixer_bc(const Args& a, LAS unsigned char* lds, bf16_t* P, int l, int nb) {
    int tid = threadIdx.x; asm volatile("" : "+v"(tid));
    LAS bf16_t* dt = (LAS bf16_t*)lds;
    const size_t r0 = (size_t)nb * 128;
    const int pos0 = (nb & 127) * 128;
    {
        u32x4 v0[PoolCfg<0>::NV], v1[PoolCfg<1>::NV], v2[PoolCfg<2>::NV], v3[PoolCfg<3>::NV];
        pool_load<0>(P, r0, pos0, tid, v0);
        bc_group<0>(a, dt, P, l, r0, pos0, tid, v0, v1);
        bc_group<1>(a, dt, P, l, r0, pos0, tid, v1, v2);
        bc_group<2>(a, dt, P, l, r0, pos0, tid, v2, v3);
        bc_group<3>(a, dt, P, l, r0, pos0, tid, v3, v0);
    }
    {
        const int cc = tid & 127, c = cc * 8, t0 = (tid >> 7) * 32;
        float w0[8], w1[8], w2[8], cb[8], qm1[8], qm2[8];
        const float* cw = a.in[I_CONVW] + (size_t)l * 3 * 1024 + c; const float* cbp = a.in[I_CONVB] + (size_t)l * 1024 + c;
        {
            const f32x4 a0 = *(const f32x4*)cw, a1 = *(const f32x4*)(cw + 4), b0 = *(const f32x4*)(cw + 1024), b1 = *(const f32x4*)(cw + 1028);
            const f32x4 c0 = *(const f32x4*)(cw + 2048), c1 = *(const f32x4*)(cw + 2052), d0 = *(const f32x4*)cbp, d1 = *(const f32x4*)(cbp + 4);
#pragma unroll
            for (int e = 0; e < 4; ++e) { w0[e] = a0[e]; w0[4 + e] = a1[e]; w1[e] = b0[e]; w1[4 + e] = b1[e]; w2[e] = c0[e]; w2[4 + e] = c1[e]; cb[e] = d0[e]; cb[4 + e] = d1[e]; }
#pragma unroll
            for (int e = 0; e < 8; ++e) { qm1[e] = 0.f; qm2[e] = 0.f; }
        }
        bf16_t* bp = P + (r0 + t0) * LDP + c;
        if (pos0 + t0 >= 2) {
            const u32x4 h1 = *(const u32x4*)(bp - LDP + S_Q), h2 = *(const u32x4*)(bp - 2 * LDP + S_Q);
            qm1[0] = bf_lo(h1.x); qm1[1] = bf_hi(h1.x); qm1[2] = bf_lo(h1.y); qm1[3] = bf_hi(h1.y); qm1[4] = bf_lo(h1.z); qm1[5] = bf_hi(h1.z); qm1[6] = bf_lo(h1.w); qm1[7] = bf_hi(h1.w);
            qm2[0] = bf_lo(h2.x); qm2[1] = bf_hi(h2.x); qm2[2] = bf_lo(h2.y); qm2[3] = bf_hi(h2.y); qm2[4] = bf_lo(h2.z); qm2[5] = bf_hi(h2.z); qm2[6] = bf_lo(h2.w); qm2[7] = bf_hi(h2.w);
        }
        u32x4 qv[3][4], zv[3][4];
#pragma unroll
        for (int pb = 0; pb < 2; ++pb)
#pragma unroll
            for (int t = 0; t < 4; ++t) { const bf16_t* rp = bp + (size_t)(pb * 4 + t) * LDP; qv[pb][t] = *(const u32x4*)(rp + S_Q); zv[pb][t] = *(const u32x4*)(rp + S_CBZ); }
#pragma unroll
        for (int bt = 0; bt < 8; ++bt) {
            if (bt < 6) {
#pragma unroll
                for (int t = 0; t < 4; ++t) { const bf16_t* rp = bp + (size_t)((bt + 2) * 4 + t) * LDP; qv[(bt + 2) % 3][t] = *(const u32x4*)(rp + S_Q); zv[(bt + 2) % 3][t] = *(const u32x4*)(rp + S_CBZ); }
            }
#pragma unroll
            for (int t = 0; t < 4; ++t) {
                const u32x4 qq = qv[bt % 3][t], zq = zv[bt % 3][t];
                float q[8], z[8], o[8];
                q[0] = bf_lo(qq.x); q[1] = bf_hi(qq.x); q[2] = bf_lo(qq.y); q[3] = bf_hi(qq.y); q[4] = bf_lo(qq.z); q[5] = bf_hi(qq.z); q[6] = bf_lo(qq.w); q[7] = bf_hi(qq.w);
                z[0] = bf_lo(zq.x); z[1] = bf_hi(zq.x); z[2] = bf_lo(zq.y); z[3] = bf_hi(zq.y); z[4] = bf_lo(zq.z); z[5] = bf_hi(zq.z); z[6] = bf_lo(zq.w); z[7] = bf_hi(zq.w);
#pragma unroll
                for (int e = 0; e < 8; ++e) { o[e] = z[e] * (w0[e] * qm2[e] + w1[e] * qm1[e] + w2[e] * q[e] + cb[e]); qm2[e] = qm1[e]; qm1[e] = q[e]; }
                u32x4 w; w.x = cvt_pk_bf16(o[0], o[1]); w.y = cvt_pk_bf16(o[2], o[3]); w.z = cvt_pk_bf16(o[4], o[5]); w.w = cvt_pk_bf16(o[6], o[7]);
                *(u32x4*)(bp + (size_t)(bt * 4 + t) * LDP + S_CBZ) = w;
            }
        }
    }
    __syncthreads();
}

constexpr int WGM_P1 = 4, WGM_P3 = 8, WGM_P4 = 8;
constexpr int PH_PER_LAYER = 5, N_PHASES = DEPTH * PH_PER_LAYER + 1;

__global__ void __launch_bounds__(NTHREADS, 2) fwd_kernel(Args a) {
    extern __shared__ __attribute__((aligned(16))) unsigned char lds_raw[];
    LAS unsigned char* lds = (LAS unsigned char*)lds_raw;
    cg::grid_group grid = cg::this_grid();
    const int G = gridDim.x;
    volatile LAS unsigned* misc = (volatile LAS unsigned*)(lds + LDS_MISC);
    if (threadIdx.x < 2) misc[threadIdx.x] = 0u;
    __syncthreads();
    XcdBarrier xbar; xbar.bar = (unsigned*)(a.ws + WS_BAR); xbar.x = 0; xbar.st = misc;
    if (a.ph_hi - a.ph_lo > 1) xbar = xcd_barrier_post((unsigned*)(a.ws + WS_BAR), misc);
    bf16_t* P = (bf16_t*)(a.ws + WS_P);
    for (int ph = a.ph_lo; ph < a.ph_hi; ++ph) {
        if (ph == N_PHASES - 1) {
            int tid = threadIdx.x; asm volatile("" : "+v"(tid));
            const int wave = __builtin_amdgcn_readfirstlane(tid >> 6);
            rms_rows_xr<false>((const bf16_t*)(a.ws + WS_XR), a.in[I_FINALG], a.out, blockIdx.x * NWAVES + wave, G * NWAVES, tid & 63);
        } else {
            const int l = ph / PH_PER_LAYER, k = ph - l * PH_PER_LAYER;
            if (k == 0) phase_p0(a, lds, l);
            else if (k == 1) {
                pg8::Gemm g{(const bf16_t*)(a.ws + WS_H), (const bf16_t*)(a.ws + WS_WIN), DM, DM, 0, 0};
                pg8::TileOrder S; S.init(MTOK, NIN, G, (int)blockIdx.x, 1, WGM_P1);
                pg8::EpiProj E{P};
                pg8::gemm_phase<pg8::EpiProj, pg8::TileOrder>(lds, g, S, E);
            } else if (k == 2) {
                for (int u = blockIdx.x; u < 512; u += G) { const int nb = u & 255; const bool bc_first = (nb & 1) != 0; const bool second = (u >= 256);
                    if (bc_first != second) mixer_bc(a, lds, P, l, nb); else mixer_a(a, lds, P, l, nb); }
            } else if (k == 3) {
                pg8::Gemm g{P + S_YA, (const bf16_t*)(a.ws + WS_WABC), LDP, DM, (size_t)Y_STRIDE, (size_t)DM * DM};
                pg8::TileOrder S; S.init(MTOK, DM, G, (int)blockIdx.x, 3, WGM_P3);
                pg8::EpiGate E{P};
                pg8::gemm_phase<pg8::EpiGate, pg8::TileOrder>(lds, g, S, E);
            } else {
                pg8::Gemm g{P + S_MG, (const bf16_t*)(a.ws + WS_WOUT), LDP, DM, 0, 0};
                pg8::TileOrder S; S.init(MTOK, DM, G, (int)blockIdx.x, 1, WGM_P4);
                pg8::EpiRes E{(bf16_t*)(a.ws + WS_XR)};
                pg8::gemm_phase<pg8::EpiRes, pg8::TileOrder>(lds, g, S, E);
            }
        }
        if (ph + 1 < a.ph_hi) { if (a.ph_hi < 0) grid.sync(); xcd_barrier(xbar); }
    }
}

extern "C" void kernel_launch(void* const* d_in, const int* in_sizes, int n_in, void* d_out, int out_size, void* d_ws, size_t ws_size, hipStream_t stream) {
    static int grid = 0;
    if (grid == 0) {
        if (n_in != 17 || in_sizes[0] != MTOK * DM || out_size != MTOK * DM || ws_size < WS_END) {
            fprintf(stderr, "kernel_launch: unexpected problem (n_in %d, in0 %d, out %d, ws %zu); nothing launched\n", n_in, n_in > 0 ? in_sizes[0] : -1, out_size, ws_size); grid = -1; return; }
        int dev = 0, cus = 0, per_cu = 0;
        if (hipGetDevice(&dev) != hipSuccess || hipDeviceGetAttribute(&cus, hipDeviceAttributeMultiprocessorCount, dev) != hipSuccess) { fprintf(stderr, "kernel_launch: device query failed\n"); grid = -1; return; }
        if (hipFuncSetAttribute((const void*)fwd_kernel, hipFuncAttributeMaxDynamicSharedMemorySize, LDS_BYTES) != hipSuccess) { fprintf(stderr, "kernel_launch: hipFuncSetAttribute failed\n"); grid = -1; return; }
        if (hipOccupancyMaxActiveBlocksPerMultiprocessor(&per_cu, (const void*)fwd_kernel, NTHREADS, LDS_BYTES) != hipSuccess || per_cu < 1) { fprintf(stderr, "kernel_launch: occupancy query says %d blocks/CU\n", per_cu); per_cu = 1; }
        (void)hipGetLastError();
        grid = cus * per_cu;
    }
    if (grid < 0) return;
    Args a{};
    for (int i = 0; i < 17; ++i) a.in[i] = (const float*)d_in[i];
    a.out = (float*)d_out; a.ws = (unsigned char*)d_ws;
#if MK_MULTI_LAUNCH
    for (int ph = 0; ph < N_PHASES; ++ph) {
        a.ph_lo = ph; a.ph_hi = ph + 1;
        hipLaunchKernelGGL(fwd_kernel, dim3(grid), dim3(NTHREADS), LDS_BYTES, stream, a);
    }
#else
    if (hipMemsetAsync((char*)d_ws + WS_BAR, 0, 16384, stream) != hipSuccess) { fprintf(stderr, "kernel_launch: memset of the barrier words failed\n"); return; }
    a.ph_lo = 0; a.ph_hi = N_PHASES;
    void* kargs[] = {&a};
    hipError_t e = hipLaunchCooperativeKernel((const void*)fwd_kernel, dim3(grid), dim3(NTHREADS), kargs, LDS_BYTES, stream);
    if (e != hipSuccess) fprintf(stderr, "kernel_launch: cooperative launch failed: %s (grid %d)\n", hipGetErrorString(e), grid);
#endif
}
```

```cpp
#include <hip/hip_runtime.h>
#include <hip/hip_cooperative_groups.h>
#include <cstdio>
#include <cstdint>
namespace cg = cooperative_groups;

#ifndef MK_MULTI_LAUNCH
#define MK_MULTI_LAUNCH 0
#endif

#define LAS __attribute__((address_space(3)))
typedef unsigned short bf16_t;
typedef short bf16x8 __attribute__((ext_vector_type(8)));
typedef short s16x4 __attribute__((ext_vector_type(4)));
typedef float f32x4 __attribute__((ext_vector_type(4)));
typedef float f32x2 __attribute__((ext_vector_type(2)));
typedef unsigned u32x4 __attribute__((ext_vector_type(4)));
typedef unsigned u32x2 __attribute__((ext_vector_type(2)));

constexpr int DM = 1024, SEQ = 16384, NBATCH = 2, MTOK = NBATCH * SEQ, DEPTH = 4, NIN = 12288;
constexpr int LDP = 1024;
constexpr size_t SEG = (size_t)MTOK * 1024;
constexpr size_t S_YA = 0, S_GV = 1 * SEG, S_BP = 2 * SEG, S_BZ = 3 * SEG, S_Q = 4 * SEG, S_G0 = 5 * SEG, S_CBZ = 6 * SEG, S_G1 = 7 * SEG, S_G2 = 8 * SEG;
constexpr size_t S_MG = S_Q, Y_STRIDE = 3 * SEG;
constexpr float RMS_EPS = 1e-6f, LN_EPS = 1e-5f;

constexpr size_t MiB = 1u << 20;
constexpr size_t WS_H = 0;
constexpr size_t WS_WIN = 64 * MiB;
constexpr size_t WS_WABC = 88 * MiB;
constexpr size_t WS_WOUT = 94 * MiB;
constexpr size_t WS_POOL = 96 * MiB;
constexpr size_t WS_SGW = 96 * MiB + 512 * 1024;
constexpr size_t WS_P = 128 * MiB;
constexpr size_t WS_BAR = 100 * MiB;
constexpr size_t WS_XR = 704 * MiB;
constexpr size_t WS_END = 768 * MiB;

constexpr int NWAVES = 8, NTHREADS = 512;
constexpr int LDS_MISC = 139264;
constexpr int LDS_BYTES = LDS_MISC + 256;

__device__ __forceinline__ unsigned cvt_pk_bf16(float lo, float hi) { unsigned r; asm volatile("v_cvt_pk_bf16_f32 %0, %1, %2" : "=v"(r) : "v"(lo), "v"(hi)); return r; }
__device__ __forceinline__ float bf_lo(unsigned u) { return __builtin_bit_cast(float, u << 16); }
__device__ __forceinline__ float bf_hi(unsigned u) { return __builtin_bit_cast(float, u & 0xffff0000u); }
__device__ __forceinline__ float sigmoid_f(float x) { return __builtin_amdgcn_rcpf(1.0f + __builtin_amdgcn_exp2f(-1.4426950409f * x)); }
__device__ __forceinline__ float wave_sum(float v) {
#pragma unroll
    for (int o = 1; o < 64; o <<= 1) v += __shfl_xor(v, o);
    return v;
}
#define LDS_WAIT() asm volatile("s_waitcnt lgkmcnt(0)" ::: "memory")

namespace pg8 {
constexpr int BM = 256, BK = 64, HALF = 128, HTB = HALF * BK * 2, STAGE_BYTES = 8 * HTB, NXCD = 8;
__host__ __device__ __forceinline__ int lds_byte(int r, int c) { const int st = (r >> 4) * 2 + (c >> 5), rr = r & 15, cc = c & 31, ob = rr * 64 + cc * 2; return st * 1024 + (ob ^ (((ob >> 9) & 1) << 5)); }
__host__ __device__ __forceinline__ void stage_rc(int b, int& R, int& C) { const int st = b / 1024, sb = b % 1024, swz = sb ^ (((sb >> 9) & 1) << 5); R = (st >> 1) * 16 + swz / 64; C = (st & 1) * 32 + (swz % 64) / 2; }
__host__ __device__ __forceinline__ int perm32(int rho) { const int n = rho >> 4, i = rho & 15; return 8 * (i >> 2) + 4 * n + (i & 3); }

struct Unit { int pm, pn, b; };
struct Gemm { const bf16_t* A; const bf16_t* Bt; int lda, K; size_t abs, bbs; };

struct TileOrder {
    int nM, nN, nwg, G, c, nb, WGM;
    __device__ void init(int M, int N, int G_, int c_, int nb_, int wgm_) { nM = M / BM; nN = N / BM; nwg = nM * nN; G = G_; c = c_; nb = nb_; WGM = wgm_; }
    __device__ bool next(int i, Unit& u) const {
        int t = i, b = 0; if (nb == 3) { t = i / 3; b = i - 3 * t; }
        const long L = (long)t * G + c; if (L >= nwg) return false;
        int wgid = (int)L; { const int q = nwg / NXCD, r = nwg % NXCD, xcd = wgid % NXCD, off = wgid / NXCD; wgid = (xcd < r ? xcd * (q + 1) : r * (q + 1) + (xcd - r) * q) + off; }
        const int nig = WGM * nN, gid = wgid / nig, fm = gid * WGM, gsz = (nM - fm) < WGM ? (nM - fm) : WGM;
        u.pm = fm + ((wgid % nig) % gsz); u.pn = (wgid % nig) / gsz; u.b = b; return true;
    }
};


struct EpiProj {
    static constexpr bool PERM = true, CHAIN = false;
    bf16_t* O;
    __device__ __forceinline__ void operator()(f32x4 (&acc)[2][2][4][2], const Unit& u, int wr, int wc, int fr, int fq) const {
        const int pn = u.pn;
        int mode; size_t ocol;
        if (pn < 8)       { mode = 4; ocol = S_YA + pn * 128; }
        else if (pn < 12) { mode = 1; ocol = S_GV + (pn - 8) * 256; }
        else if (pn < 16) { mode = 0; ocol = S_BP + (pn - 12) * 256; }
        else if (pn < 24) { mode = 5; ocol = S_Q + (pn - 16) * 128; }
        else if (pn < 32) { mode = 6; ocol = S_CBZ + (pn - 24) * 128; }
        else              { mode = 7; ocol = 0; }
        if (mode == 7) {
            const int row0q = u.pm * BM + wr * 64 + fr; const int ch = 64 * (pn - 32) + 16 * wc + 4 * fq;
#pragma unroll
            for (int ai = 0; ai < 2; ++ai)
#pragma unroll
                for (int m = 0; m < 4; ++m) {
                    bf16_t* rowp = O + (size_t)(row0q + ai * HALF + m * 16) * LDP + ch;
                    float r0v[4], r1v[4], g2v[4], szv[4];
#pragma unroll
                    for (int j = 0; j < 4; ++j) {
                        const float ea = fminf(__builtin_amdgcn_exp2f(-1.4426950409f * acc[ai][0][m][0][j]), 1e30f);
                        const float eb = fminf(__builtin_amdgcn_exp2f(-1.4426950409f * acc[ai][0][m][1][j]), 1e30f);
                        const float ec = fminf(__builtin_amdgcn_exp2f(-1.4426950409f * acc[ai][1][m][0][j]), 1e30f);
                        const float xz = acc[ai][1][m][1][j];
                        const float ia = __builtin_amdgcn_rcpf(1.0f + ea), ib = __builtin_amdgcn_rcpf(1.0f + eb), ic = __builtin_amdgcn_rcpf(1.0f + ec);
                        r0v[j] = (1.0f + eb) * ia; r1v[j] = (1.0f + ec) * ib; g2v[j] = ic; szv[j] = xz * sigmoid_f(xz);
                    }
                    u32x2 wr0, wr1, wg2, wsz;
                    wr0.x = cvt_pk_bf16(r0v[0], r0v[1]); wr0.y = cvt_pk_bf16(r0v[2], r0v[3]);
                    wr1.x = cvt_pk_bf16(r1v[0], r1v[1]); wr1.y = cvt_pk_bf16(r1v[2], r1v[3]);
                    wg2.x = cvt_pk_bf16(g2v[0], g2v[1]); wg2.y = cvt_pk_bf16(g2v[2], g2v[3]);
                    wsz.x = cvt_pk_bf16(szv[0], szv[1]); wsz.y = cvt_pk_bf16(szv[2], szv[3]);
                    const bool odd = (fq & 1) != 0;
                    const u32x2 s0 = odd ? wr0 : wg2, s1 = odd ? wr1 : wsz;
                    u32x2 q0, q1;
                    q0.x = (unsigned)__shfl_xor((int)s0.x, 16); q0.y = (unsigned)__shfl_xor((int)s0.y, 16);
                    q1.x = (unsigned)__shfl_xor((int)s1.x, 16); q1.y = (unsigned)__shfl_xor((int)s1.y, 16);
                    u32x4 o0, o1;
                    if (!odd) { o0 = (u32x4){wr0.x, wr0.y, q0.x, q0.y}; o1 = (u32x4){wr1.x, wr1.y, q1.x, q1.y}; }
                    else      { o0 = (u32x4){q0.x, q0.y, wg2.x, wg2.y}; o1 = (u32x4){q1.x, q1.y, wsz.x, wsz.y}; }
                    bf16_t* rp8 = rowp - (odd ? 4 : 0);
                    *(u32x4*)(rp8 + (odd ? S_G2 : S_G0)) = o0;
                    *(u32x4*)(rp8 + (odd ? S_BZ : S_G1)) = o1;
                }
            return;
        }
        const int row0 = u.pm * BM + wr * 64 + fr; const size_t col0 = ocol + wc * 32 + 8 * fq;
        if (mode >= 4) {
#pragma unroll
            for (int ai = 0; ai < 2; ++ai)
#pragma unroll
                for (int m = 0; m < 4; ++m) { bf16_t* rowp = O + (size_t)(row0 + ai * HALF + m * 16) * LDP + col0;
                    float v[8];
#pragma unroll
                    for (int j = 0; j < 8; ++j) {
                        const float x0 = acc[ai][0][m][j >> 2][j & 3], x1 = acc[ai][1][m][j >> 2][j & 3];
                        const float f0 = (mode == 4) ? x0 * sigmoid_f(1.5957691216f * (x0 + 0.044715f * x0 * x0 * x0)) : x0;
                        const float f1 = (mode == 5) ? x1 : x1 * sigmoid_f(x1);
                        v[j] = f0 * f1;
                    }
                    u32x4 w; w.x = cvt_pk_bf16(v[0], v[1]); w.y = cvt_pk_bf16(v[2], v[3]); w.z = cvt_pk_bf16(v[4], v[5]); w.w = cvt_pk_bf16(v[6], v[7]);
                    *(u32x4*)rowp = w; }
        } else {
#pragma unroll
            for (int ai = 0; ai < 2; ++ai)
#pragma unroll
                for (int m = 0; m < 4; ++m) { bf16_t* rowp = O + (size_t)(row0 + ai * HALF + m * 16) * LDP + col0;
#pragma unroll
                    for (int bj = 0; bj < 2; ++bj) {
                        float v[8];
#pragma unroll
                        for (int j = 0; j < 4; ++j) { v[j] = acc[ai][bj][m][0][j]; v[4 + j] = acc[ai][bj][m][1][j]; }
                        if (mode != 0) {
#pragma unroll
                            for (int j = 0; j < 8; ++j) {
                                const float x = v[j];
                                const float a = (mode == 1) ? 1.5957691216f * (x + 0.044715f * x * x * x) : x;
                                const float sg = sigmoid_f(a);
                                v[j] = (mode == 3) ? sg : x * sg;
                            }
                        }
                        u32x4 w; w.x = cvt_pk_bf16(v[0], v[1]); w.y = cvt_pk_bf16(v[2], v[3]); w.z = cvt_pk_bf16(v[4], v[5]); w.w = cvt_pk_bf16(v[6], v[7]);
                        *(u32x4*)(rowp + bj * HALF) = w; } }
        }
    }
};
struct EpiGate {
    static constexpr bool PERM = true, CHAIN = true;
    bf16_t* P;
    __device__ __forceinline__ void operator()(f32x4 (&acc)[2][2][4][2], const Unit& u, int wr, int wc, int fr, int fq) const {
        const int b = u.b; const size_t goff = (b == 0) ? S_G0 : (b == 1 ? S_G1 : S_G2);
        const int row0 = u.pm * BM + wr * 64 + fr, col0 = u.pn * BM + wc * 32 + 8 * fq;
        const bf16_t* gb = P + goff + (size_t)(u.pm * BM + wr * 64) * LDP + u.pn * BM;
        const unsigned go = (unsigned)(fr * LDP + wc * 32 + 8 * fq);
        u32x4 gw[2][4][2];
#pragma unroll
        for (int ai = 0; ai < 2; ++ai)
#pragma unroll
            for (int m = 0; m < 4; ++m)
#pragma unroll
                for (int bj = 0; bj < 2; ++bj) gw[ai][m][bj] = *(const u32x4*)(gb + (ai * HALF + m * 16) * LDP + bj * HALF + go);
#pragma unroll
        for (int ai = 0; ai < 2; ++ai)
#pragma unroll
            for (int m = 0; m < 4; ++m)
#pragma unroll
                for (int bj = 0; bj < 2; ++bj) {
                    const u32x4 g = gw[ai][m][bj];
                    f32x4 v0 = acc[ai][bj][m][0], v1 = acc[ai][bj][m][1];
                    v0[0] *= bf_lo(g.x); v0[1] *= bf_hi(g.x); v0[2] *= bf_lo(g.y); v0[3] *= bf_hi(g.y); v1[0] *= bf_lo(g.z); v1[1] *= bf_hi(g.z); v1[2] *= bf_lo(g.w); v1[3] *= bf_hi(g.w);
                    if (b != 2) { acc[ai][bj][m][0] = v0; acc[ai][bj][m][1] = v1; }
                    else { u32x4 w; w.x = cvt_pk_bf16(v0[0], v0[1]); w.y = cvt_pk_bf16(v0[2], v0[3]); w.z = cvt_pk_bf16(v1[0], v1[1]); w.w = cvt_pk_bf16(v1[2], v1[3]);
                        *(u32x4*)(P + (size_t)(row0 + ai * HALF + m * 16) * LDP + S_MG + col0 + bj * HALF) = w; }
                }
    }
};
struct EpiRes {
    static constexpr bool PERM = true, CHAIN = false;
    bf16_t* XR;
    __device__ __forceinline__ void operator()(f32x4 (&acc)[2][2][4][2], const Unit& u, int wr, int wc, int fr, int fq) const {
        bf16_t* xb = XR + (size_t)(u.pm * BM + wr * 64) * DM + u.pn * BM;
        const unsigned lo = (unsigned)(fr * DM + wc * 32 + 8 * fq);
        u32x4 xv[2][4][2];
#pragma unroll
        for (int ai = 0; ai < 2; ++ai)
#pragma unroll
            for (int m = 0; m < 4; ++m)
#pragma unroll
                for (int bj = 0; bj < 2; ++bj) xv[ai][m][bj] = *(const u32x4*)(xb + (ai * HALF + m * 16) * DM + bj * HALF + lo);
#pragma unroll
        for (int ai = 0; ai < 2; ++ai)
#pragma unroll
            for (int m = 0; m < 4; ++m)
#pragma unroll
                for (int bj = 0; bj < 2; ++bj) {
                    const u32x4 x = xv[ai][m][bj]; const f32x4 v0 = acc[ai][bj][m][0], v1 = acc[ai][bj][m][1];
                    u32x4 w;
                    w.x = cvt_pk_bf16(bf_lo(x.x) + v0[0], bf_hi(x.x) + v0[1]); w.y = cvt_pk_bf16(bf_lo(x.y) + v0[2], bf_hi(x.y) + v0[3]);
                    w.z = cvt_pk_bf16(bf_lo(x.z) + v1[0], bf_hi(x.z) + v1[1]); w.w = cvt_pk_bf16(bf_lo(x.w) + v1[2], bf_hi(x.w) + v1[3]);
                    *(u32x4*)(xb + (ai * HALF + m * 16) * DM + bj * HALF + lo) = w;
                }
    }
};

template <class Epi, class Sched>
__device__ __forceinline__ void gemm_phase(LAS unsigned char* lds, const Gemm g, const Sched& S, const Epi& E) {
    int tid = threadIdx.x; asm volatile("" : "+v"(tid));
    const int wid = __builtin_amdgcn_readfirstlane(tid >> 6), lane = tid & 63, wr = wid >> 2, wc = wid & 3, fr = lane & 15, fq = lane >> 4;
    const int K = g.K, nt = K / BK;
    unsigned voffA[2], voffB[2];
#pragma unroll
    for (int i = 0; i < 2; ++i) { int R, C; stage_rc(tid * 16 + i * 8192, R, C); const int Rb = Epi::PERM ? ((R & ~31) + perm32(R & 31)) : R;
        voffA[i] = (unsigned)(R * g.lda + C) * 2u; voffB[i] = (unsigned)(Rb * K + C) * 2u; }
    const size_t kstep = (size_t)(BK * 2);
    const size_t hstepA = (size_t)HALF * g.lda * 2, hstepB = (size_t)HALF * K * 2;
    const size_t tstepA = 2 * hstepA, tstepB = 2 * hstepB;
    const unsigned ldsw = (unsigned)wid * 1024u;
    const int aoff = lds_byte(wr * 64 + fr, fq * 8), boff = lds_byte(wc * 32 + fr, fq * 8);
#define PG8_SA(b, h) (((b) * 2 + (h)) * HTB)
#define PG8_SB(b, h) ((4 + (b) * 2 + (h)) * HTB)
#define PG8_STAGE(bufoff, gbase, voff) do { _Pragma("unroll") for (int _i = 0; _i < 2; ++_i) \
        __builtin_amdgcn_global_load_lds((const unsigned*)((const char*)(gbase) + (voff)[_i]), (LAS unsigned*)(lds + (bufoff) + ldsw + _i * 8192), 16, 0, 0); } while (0)
#define PG8_LDA(dst, b, h) do { _Pragma("unroll") for (int m = 0; m < 4; ++m) _Pragma("unroll") for (int k = 0; k < 2; ++k) dst[m][k] = *(const LAS bf16x8*)(lds + PG8_SA(b, h) + aoff + m * 2048 + k * 1024); } while (0)
#define PG8_LDB(dst, b, h) do { _Pragma("unroll") for (int n = 0; n < 2; ++n) _Pragma("unroll") for (int k = 0; k < 2; ++k) dst[n][k] = *(const LAS bf16x8*)(lds + PG8_SB(b, h) + boff + n * 2048 + k * 1024); } while (0)
#define PG8_MMA(ai, bj, At, Bt) do { __builtin_amdgcn_s_setprio(1); _Pragma("unroll") for (int m = 0; m < 4; ++m) _Pragma("unroll") for (int n = 0; n < 2; ++n) _Pragma("unroll") for (int k = 0; k < 2; ++k) \
        acc[ai][bj][m][n] = __builtin_amdgcn_mfma_f32_16x16x32_bf16(Bt[n][k], At[m][k], acc[ai][bj][m][n], 0, 0, 0); __builtin_amdgcn_s_setprio(0); } while (0)
#define PG8_WAIT_V(n) asm volatile("s_waitcnt vmcnt(" #n ")" ::: "memory")
#define PG8_WAIT_L(n) asm volatile("s_waitcnt lgkmcnt(" #n ")" ::: "memory")
#define PG8_BAR __builtin_amdgcn_s_barrier()
#define PG8_SCHED __builtin_amdgcn_sched_barrier(0)
    Unit cur, nxt; int ui = 0;
    if (!S.next(0, cur)) return;
    f32x4 acc[2][2][4][2];
#pragma unroll
    for (int a = 0; a < 2; ++a)
#pragma unroll
        for (int b = 0; b < 2; ++b)
#pragma unroll
            for (int m = 0; m < 4; ++m)
#pragma unroll
                for (int n = 0; n < 2; ++n) acc[a][b][m][n] = (f32x4){0.f, 0.f, 0.f, 0.f};
    bf16x8 At[4][2], B0[2][2], B1[2][2];
    const char* cA = (const char*)g.A + (size_t)cur.b * g.abs * 2 + (size_t)cur.pm * tstepA;
    const char* cB = (const char*)g.Bt + (size_t)cur.b * g.bbs * 2 + (size_t)cur.pn * tstepB;
    PG8_STAGE(PG8_SB(0, 0), cB, voffB); PG8_STAGE(PG8_SB(0, 1), cB + hstepB, voffB); PG8_STAGE(PG8_SA(0, 0), cA, voffA); PG8_STAGE(PG8_SA(0, 1), cA + hstepA, voffA);
    if (wr == 1) PG8_BAR;
    PG8_WAIT_V(2); PG8_BAR;
    PG8_STAGE(PG8_SB(1, 0), cB + kstep, voffB); PG8_STAGE(PG8_SA(1, 0), cA + kstep, voffA); PG8_STAGE(PG8_SB(1, 1), cB + hstepB + kstep, voffB);
    PG8_WAIT_V(6); PG8_BAR;
    for (;;) {
        const bool has_next = S.next(ui + 1, nxt);
        const char* nA = has_next ? (const char*)g.A + (size_t)nxt.b * g.abs * 2 + (size_t)nxt.pm * tstepA : cA;
        const char* nB = has_next ? (const char*)g.Bt + (size_t)nxt.b * g.bbs * 2 + (size_t)nxt.pn * tstepB : cB;
        for (int t = 0; t < nt; t += 2) {
            const bool last = (t == nt - 2);
            const char* a1 = cA + (size_t)(t + 1) * kstep;
            const char* a2 = last ? nA : cA + (size_t)(t + 2) * kstep; const char* b2 = last ? nB : cB + (size_t)(t + 2) * kstep;
            const char* a3 = a2 + kstep; const char* b3 = b2 + kstep;
            PG8_LDB(B0, 0, 0); PG8_LDB(B1, 0, 1); PG8_SCHED; PG8_LDA(At, 0, 0); PG8_STAGE(PG8_SA(1, 1), a1 + hstepA, voffA);
            PG8_WAIT_V(8); PG8_WAIT_L(0); PG8_BAR; PG8_MMA(0, 0, At, B0); PG8_MMA(0, 1, At, B1); PG8_BAR; PG8_SCHED;
            PG8_LDA(At, 0, 1); PG8_STAGE(PG8_SB(0, 0), b2, voffB); PG8_STAGE(PG8_SB(0, 1), b2 + hstepB, voffB); PG8_STAGE(PG8_SA(0, 0), a2, voffA);
            PG8_WAIT_V(8); PG8_WAIT_L(0); PG8_BAR; PG8_MMA(1, 0, At, B0); PG8_MMA(1, 1, At, B1); PG8_BAR; PG8_SCHED;
            PG8_LDB(B0, 1, 0); PG8_LDB(B1, 1, 1); PG8_SCHED; PG8_LDA(At, 1, 0); PG8_STAGE(PG8_SA(0, 1), a2 + hstepA, voffA);
            PG8_WAIT_V(8); PG8_WAIT_L(0); PG8_BAR; PG8_MMA(0, 0, At, B0); PG8_MMA(0, 1, At, B1); PG8_BAR; PG8_SCHED;
            PG8_LDA(At, 1, 1); PG8_STAGE(PG8_SB(1, 0), b3, voffB); PG8_STAGE(PG8_SB(1, 1), b3 + hstepB, voffB); PG8_STAGE(PG8_SA(1, 0), a3, voffA);
            PG8_WAIT_V(8); PG8_WAIT_L(0); PG8_BAR; PG8_MMA(1, 0, At, B0); PG8_MMA(1, 1, At, B1); PG8_BAR; PG8_SCHED;
        }
        if (wr == 0) PG8_BAR;
        E(acc, cur, wr, wc, fr, fq);
        if (!has_next) break;
        if (!(Epi::CHAIN && nxt.b != 0)) {
#pragma unroll
        for (int a = 0; a < 2; ++a)
#pragma unroll
            for (int b = 0; b < 2; ++b)
#pragma unroll
                for (int m = 0; m < 4; ++m)
#pragma unroll
                    for (int n = 0; n < 2; ++n) acc[a][b][m][n] = (f32x4){0.f, 0.f, 0.f, 0.f};
        }
        cur = nxt; cA = nA; cB = nB; ++ui;
        if (wr == 1) PG8_BAR;
    }
    PG8_WAIT_V(0);
    PG8_BAR;
#undef PG8_SA
#undef PG8_SB
#undef PG8_STAGE
#undef PG8_LDA
#undef PG8_LDB
#undef PG8_MMA
#undef PG8_WAIT_V
#undef PG8_WAIT_L
#undef PG8_BAR
#undef PG8_SCHED
}
}


#define XB_TMO      128
#define XB_XCNT(j)  (256  + 64 * (j))
#define XB_XSUB(j)  (1280 + 64 * (j))
#define XB_XGEN(j)  (2304 + 64 * (j))
#define XB_TOP      3328
#define XB_TOPGEN   3392
#define XCD_BAR_WORDS 3456
#define XB_SPIN_CAP (1u << 18)
__device__ __forceinline__ unsigned xb_ld(unsigned* p)              { return __hip_atomic_load(p, __ATOMIC_RELAXED, __HIP_MEMORY_SCOPE_AGENT); }
__device__ __forceinline__ unsigned xb_add(unsigned* p, unsigned v) { return __hip_atomic_fetch_add(p, v, __ATOMIC_RELAXED, __HIP_MEMORY_SCOPE_AGENT); }
__device__ __forceinline__ unsigned xb_xcc_id() { return (unsigned)__builtin_amdgcn_s_getreg((3 << 11) | 20) & 0xFu; }
#define XB_SPIN(cond, bar) do { unsigned _sp = 0; while (cond) { __builtin_amdgcn_s_sleep(1); \
    if ((++_sp & 255u) == 0u) { if (xb_ld(&(bar)[XB_TMO])) break; if (_sp > XB_SPIN_CAP) { atomicAdd(&(bar)[XB_TMO], 1u); break; } } } } while (0)
struct XcdBarrier { unsigned* bar; unsigned x; volatile LAS unsigned* st; };
__device__ __forceinline__ XcdBarrier xcd_barrier_post(unsigned* bar, volatile LAS unsigned* st) {
    XcdBarrier b; b.bar = bar; b.x = xb_xcc_id(); b.st = st;
    if (threadIdx.x == 0) (void)xb_add(&bar[XB_XCNT(b.x)], 1u);
    return b;
}
__device__ __forceinline__ void xcd_barrier_complete(unsigned* bar, unsigned x, unsigned& nloc, unsigned& nx) {
    const unsigned G = gridDim.x * gridDim.y * gridDim.z;
    unsigned sum, cnt, mine, sp = 0u;
    for (;;) {
        sum = 0u; cnt = 0u; mine = 0u;
#pragma unroll
        for (unsigned j = 0; j < 16; ++j) { const unsigned c = xb_ld(&bar[XB_XCNT(j)]); sum += c; cnt += (c > 0u) ? 1u : 0u; mine = (j == x) ? c : mine; }
        if (sum == G) break;
        __builtin_amdgcn_s_sleep(1);
        if ((++sp & 255u) == 0u) { if (xb_ld(&bar[XB_TMO])) break; if (sp > XB_SPIN_CAP) { atomicAdd(&bar[XB_TMO], 1u); break; } }
    }
    nloc = mine > 0u ? mine : 1u; nx = cnt > 0u ? cnt : 1u;
}
__device__ __forceinline__ void xcd_barrier(const XcdBarrier& b) {
    asm volatile("s_waitcnt vmcnt(0)" ::: "memory");
    __syncthreads();
    if (threadIdx.x == 0) {
        unsigned* bar = b.bar;
        __builtin_amdgcn_s_waitcnt(0);
        unsigned nloc = b.st[0], nx = b.st[1];
        if (nloc == 0u) { xcd_barrier_complete(bar, b.x, nloc, nx); b.st[0] = nloc; b.st[1] = nx; }
        const unsigned old = xb_add(&bar[XB_XSUB(b.x)], 1u);
        const unsigned gen = old / nloc;
        if (old + 1u == (gen + 1u) * nloc) {
            __builtin_amdgcn_fence(__ATOMIC_RELEASE, "agent");
            asm volatile("s_waitcnt vmcnt(0)" ::: "memory");
            const unsigned og = xb_add(&bar[XB_TOP], 1u);
            const unsigned tg = og / nx;
            if (og + 1u == (tg + 1u) * nx) xb_add(&bar[XB_TOPGEN], 1u);
            else XB_SPIN(xb_ld(&bar[XB_TOPGEN]) == tg, bar);
            __builtin_amdgcn_fence(__ATOMIC_ACQUIRE, "agent");
            xb_add(&bar[XB_XGEN(b.x)], 1u);
            asm volatile("s_waitcnt vmcnt(0)" ::: "memory");
        } else {
            XB_SPIN(xb_ld(&bar[XB_XGEN(b.x)]) == gen, bar);
            __builtin_amdgcn_fence(__ATOMIC_ACQUIRE, "agent");
            asm volatile("s_waitcnt vmcnt(0)" ::: "memory");
        }
    }
    __syncthreads();
}

struct Args { const float* in[17]; float* out; unsigned char* ws; int ph_lo, ph_hi; };
enum { I_X = 0, I_NORMG, I_WIN, I_LNG, I_LNB, I_SGW, I_SGB, I_POOLW, I_POOLB, I_POOLS, I_CONVW, I_CONVB, I_WA, I_WB, I_WC, I_WOUT, I_FINALG };

__device__ __forceinline__ int map_col(int n) {
    const int sg = n >> 10, j = n & 1023, pj = (j >> 7) * 256 + (j & 127);
    int st;
    switch (sg) {
        case 0: return pj;
        case 2: return pj + 128;
        case 1: return 2048 + j;
        case 3: return 3072 + j;
        case 5: return 4096 + pj;
        case 7: return 4096 + pj + 128;
        case 6: return 6144 + pj;
        case 8: return 6144 + pj + 128;
        case 9: st = 0; break;
        case 10: st = 1; break;
        case 11: st = 2; break;
        default: st = 3; break;
    }
    const int q = j >> 6, r = j & 63, wc = r >> 4, fq = (r >> 2) & 3, jj = r & 3;
    return 8192 + 256 * q + 128 * (st >> 1) + 32 * wc + 8 * fq + 4 * (st & 1) + jj;
}
struct TItem { const float* W; bf16_t* WT; int K, N, r, map; };
__device__ __forceinline__ void titem_load(const TItem& t, int lane, f32x4 (&tv)[8]) {
    const int nblk = t.N / 32, kb = t.r / nblk, nb = t.r - kb * nblk;
    const float* p = t.W + (size_t)(64 * kb + (lane >> 3)) * t.N + 32 * nb + 4 * (lane & 7);
#pragma unroll
    for (int i = 0; i < 8; ++i) tv[i] = *(const f32x4*)(p + (size_t)(8 * i) * t.N);
}
__device__ __forceinline__ void titem_store(const TItem& t, int lane, const f32x4 (&tv)[8], LAS float* scr) {
    const int nblk = t.N / 32, kb = t.r / nblk, nb = t.r - kb * nblk, k0 = 64 * kb, n0 = 32 * nb;
#pragma unroll
    for (int i = 0; i < 8; ++i) { LAS float* d = scr + (8 * i + (lane >> 3)) * 33 + 4 * (lane & 7); d[0] = tv[i].x; d[1] = tv[i].y; d[2] = tv[i].z; d[3] = tv[i].w; }
    LDS_WAIT(); asm volatile("" ::: "memory");
    const int c = lane & 7;
#pragma unroll
    for (int j = 0; j < 4; ++j) { const int n = (lane >> 3) + 8 * j; const LAS float* sp = scr + (8 * c) * 33 + n;
        u32x4 o; o.x = cvt_pk_bf16(sp[0 * 33], sp[1 * 33]); o.y = cvt_pk_bf16(sp[2 * 33], sp[3 * 33]); o.z = cvt_pk_bf16(sp[4 * 33], sp[5 * 33]); o.w = cvt_pk_bf16(sp[6 * 33], sp[7 * 33]);
        const int row = t.map ? map_col(n0 + n) : n0 + n;
        *(u32x4*)(t.WT + (size_t)row * t.K + k0 + 8 * c) = o; }
    LDS_WAIT(); asm volatile("" ::: "memory");
}

template <bool OUT_BF16>
__device__ __forceinline__ void rms_rows(const float* X, const float* gvec, void* out, int gw, int NGW, int lane, bf16_t* xcopy = nullptr) {
    f32x4 gv[4];
#pragma unroll
    for (int j = 0; j < 4; ++j) gv[j] = *((const f32x4*)gvec + lane + 64 * j);
    for (int m0 = gw; m0 < MTOK; m0 += 4 * NGW) {
        f32x4 v[4][4]; float s[4];
#pragma unroll
        for (int q = 0; q < 4; ++q) { const int m = m0 + q * NGW; const f32x4* xr = (const f32x4*)(X + (size_t)(m < MTOK ? m : m0) * DM) + lane;
#pragma unroll
            for (int j = 0; j < 4; ++j) v[q][j] = xr[64 * j]; }
#pragma unroll
        for (int q = 0; q < 4; ++q) { float t = 0.f;
#pragma unroll
            for (int j = 0; j < 4; ++j) t += (v[q][j].x * v[q][j].x + v[q][j].y * v[q][j].y) + (v[q][j].z * v[q][j].z + v[q][j].w * v[q][j].w);
            s[q] = t; }
#pragma unroll
        for (int o = 1; o < 64; o <<= 1)
#pragma unroll
            for (int q = 0; q < 4; ++q) s[q] += __shfl_xor(s[q], o);
#pragma unroll
        for (int q = 0; q < 4; ++q) {
            const int m = m0 + q * NGW; if (m >= MTOK) break;
            const float r = 1.0f / sqrtf(s[q] * (1.f / DM) + RMS_EPS);
            if (xcopy) { u32x2* oc = (u32x2*)(xcopy + (size_t)m * DM) + lane;
#pragma unroll
                for (int j = 0; j < 4; ++j) { u32x2 w; w.x = cvt_pk_bf16(v[q][j].x, v[q][j].y); w.y = cvt_pk_bf16(v[q][j].z, v[q][j].w); oc[64 * j] = w; } }
            if (OUT_BF16) {
                u32x2* o = (u32x2*)((bf16_t*)out + (size_t)m * DM) + lane;
#pragma unroll
                for (int j = 0; j < 4; ++j) { u32x2 w; w.x = cvt_pk_bf16(v[q][j].x * r * gv[j].x, v[q][j].y * r * gv[j].y); w.y = cvt_pk_bf16(v[q][j].z * r * gv[j].z, v[q][j].w * r * gv[j].w); o[64 * j] = w; }
            } else {
                f32x4* o = (f32x4*)((float*)out + (size_t)m * DM) + lane;
#pragma unroll
                for (int j = 0; j < 4; ++j) o[64 * j] = v[q][j] * r * gv[j];
            }
        }
    }
}

template <bool OUT_BF16>
__device__ __forceinline__ void rms_rows_xr(const bf16_t* X, const float* gvec, void* out, int gw, int NGW, int lane) {
    f32x4 gv[2][2];
#pragma unroll
    for (int j = 0; j < 2; ++j) { gv[j][0] = *(const f32x4*)(gvec + lane * 8 + 512 * j); gv[j][1] = *(const f32x4*)(gvec + lane * 8 + 512 * j + 4); }
    for (int m0 = gw; m0 < MTOK; m0 += 4 * NGW) {
        u32x4 q[4][2]; float s[4];
#pragma unroll
        for (int r = 0; r < 4; ++r) { const int m = m0 + r * NGW; const bf16_t* xr = X + (size_t)(m < MTOK ? m : m0) * DM + lane * 8;
            q[r][0] = *(const u32x4*)xr; q[r][1] = *(const u32x4*)(xr + 512); }
        float v[4][2][8];
#pragma unroll
        for (int r = 0; r < 4; ++r) { float t = 0.f;
#pragma unroll
            for (int j = 0; j < 2; ++j) { const u32x4 z = q[r][j];
                v[r][j][0] = bf_lo(z.x); v[r][j][1] = bf_hi(z.x); v[r][j][2] = bf_lo(z.y); v[r][j][3] = bf_hi(z.y); v[r][j][4] = bf_lo(z.z); v[r][j][5] = bf_hi(z.z); v[r][j][6] = bf_lo(z.w); v[r][j][7] = bf_hi(z.w);
#pragma unroll
                for (int e = 0; e < 8; ++e) t += v[r][j][e] * v[r][j][e]; }
            s[r] = t; }
#pragma unroll
        for (int o = 1; o < 64; o <<= 1)
#pragma unroll
            for (int r = 0; r < 4; ++r) s[r] += __shfl_xor(s[r], o);
#pragma unroll
        for (int r = 0; r < 4; ++r) {
            const int m = m0 + r * NGW; if (m >= MTOK) break;
            const float rs = 1.0f / sqrtf(s[r] * (1.f / DM) + RMS_EPS);
#pragma unroll
            for (int j = 0; j < 2; ++j) {
                float y[8];
#pragma unroll
                for (int e = 0; e < 8; ++e) y[e] = v[r][j][e] * rs * gv[j][e >> 2][e & 3];
                if (OUT_BF16) { u32x4 w; w.x = cvt_pk_bf16(y[0], y[1]); w.y = cvt_pk_bf16(y[2], y[3]); w.z = cvt_pk_bf16(y[4], y[5]); w.w = cvt_pk_bf16(y[6], y[7]);
                    *(u32x4*)((bf16_t*)out + (size_t)m * DM + lane * 8 + 512 * j) = w; }
                else { float* o = (float*)out + (size_t)m * DM + lane * 8 + 512 * j; *(f32x4*)o = (f32x4){y[0], y[1], y[2], y[3]}; *(f32x4*)(o + 4) = (f32x4){y[4], y[5], y[6], y[7]}; }
            }
        }
    }
}

__device__ __forceinline__ void phase_p0(const Args& a, LAS unsigned char* lds, int l) {
    int tid = threadIdx.x; asm volatile("" : "+v"(tid));
    const int lane = tid & 63, wave = __builtin_amdgcn_readfirstlane(tid >> 6);
    const int G = gridDim.x, gw = blockIdx.x * NWAVES + wave, NGW = G * NWAVES;
    LAS float* scr = (LAS float*)(lds + wave * 16384);
    bf16_t* WIN = (bf16_t*)(a.ws + WS_WIN); bf16_t* WABC = (bf16_t*)(a.ws + WS_WABC); bf16_t* WOUT = (bf16_t*)(a.ws + WS_WOUT);
    bf16_t* POOL = (bf16_t*)(a.ws + WS_POOL); bf16_t* SGW = (bf16_t*)(a.ws + WS_SGW);
    constexpr int IT_IN = (DM / 64) * (NIN / 32), IT_SQ = (DM / 64) * (DM / 32);
    constexpr int NITEMS = IT_IN + 4 * IT_SQ;
    if (l == 0) rms_rows<true>(a.in[I_X], a.in[I_NORMG], a.ws + WS_H, gw, NGW, lane, (bf16_t*)(a.ws + WS_XR));
    else rms_rows_xr<true>((const bf16_t*)(a.ws + WS_XR), a.in[I_NORMG] + (size_t)l * DM, a.ws + WS_H, gw, NGW, lane);
#define P0_DECODE(T, IT) do { int r_ = (IT); \
        if (r_ < IT_IN) { T = TItem{a.in[I_WIN] + (size_t)l * DM * NIN, WIN, DM, NIN, r_, 1}; } \
        else if ((r_ -= IT_IN) < IT_SQ) { T = TItem{a.in[I_WA] + (size_t)l * DM * DM, WABC, DM, DM, r_, 0}; } \
        else if ((r_ -= IT_SQ) < IT_SQ) { T = TItem{a.in[I_WB] + (size_t)l * DM * DM, WABC + (size_t)DM * DM, DM, DM, r_, 0}; } \
        else if ((r_ -= IT_SQ) < IT_SQ) { T = TItem{a.in[I_WC] + (size_t)l * DM * DM, WABC + (size_t)2 * DM * DM, DM, DM, r_, 0}; } \
        else { r_ -= IT_SQ; T = TItem{a.in[I_WOUT] + (size_t)l * DM * DM, WOUT, DM, DM, r_, 0}; } } while (0)
    {
        int it = gw;
        TItem cur{}, nxt{}; f32x4 tva[8], tvb[8];
        if (it < NITEMS) { P0_DECODE(cur, it); titem_load(cur, lane, tva); }
        while (it < NITEMS) {
            const int nx = it + NGW;
            if (nx < NITEMS) { P0_DECODE(nxt, nx); titem_load(nxt, lane, tvb); }
            titem_store(cur, lane, tva, scr);
#pragma unroll
            for (int i = 0; i < 8; ++i) tva[i] = tvb[i];
            cur = nxt; it = nx;
        }
    }
#undef P0_DECODE
    for (int e = blockIdx.x * NTHREADS + tid; e < 4 * 256 * 64; e += G * NTHREADS) {
        const int d = e & 255, c4 = (e >> 8) & 63, pg = e >> 14;
        const float* src = a.in[I_POOLW] + (size_t)(l * 4 + pg) * 65536 + (size_t)(4 * c4) * 256 + d;
        u32x2 o; o.x = cvt_pk_bf16(src[0], src[256]); o.y = cvt_pk_bf16(src[512], src[768]);
        *(u32x2*)(POOL + (size_t)pg * 65536 + (size_t)d * 256 + 4 * c4) = o;
    }
    for (int e = blockIdx.x * NTHREADS + tid; e < 8 * 128 * 128 / 4; e += G * NTHREADS) {
        const f32x4 w = *((const f32x4*)(a.in[I_SGW] + (size_t)l * 8 * 128 * 128) + e);
        const int idx = e * 4, i = (idx >> 7) & 127, j = idx & 127;
        const bool keep = (j >> 6) <= (i >> 6);
        u32x2 o; o.x = keep ? cvt_pk_bf16(w.x, w.y) : 0u; o.y = keep ? cvt_pk_bf16(w.z, w.w) : 0u;
        *((u32x2*)SGW + e) = o;
    }
}

__device__ __forceinline__ void mixer_a(const Args& a, LAS unsigned char* lds, bf16_t* P, int l, int nb) {
    int tid = threadIdx.x; asm volatile("" : "+v"(tid));
    const int lane = tid & 63, wave = __builtin_amdgcn_readfirstlane(tid >> 6), fr = lane & 15, fq = lane >> 4;
    LAS f32x2* stat = (LAS f32x2*)lds;
    constexpr int VS = 132, VBUF = 128 * VS;
    constexpr int WSS = 136, WBUF = 128 * WSS;
    LAS bf16_t* vn0 = (LAS bf16_t*)(lds + 1024);
    LAS bf16_t* wsm0 = (LAS bf16_t*)(lds + 1024 + 2 * VBUF * 2);
    const size_t r0 = (size_t)nb * 128;
    const bf16_t* SGW = (const bf16_t*)(a.ws + WS_SGW);
    const int cc = tid & 15, jr = tid >> 4;
    u32x4 raw[4], wreg[4]; f32x4 lnp[4]; u32x4 az_n[4]; float bias_n[4];
    const int blk = wave & 3, hrow = wave >> 2;
#define ITL(i4) ((((i4) >> 1) << 2) + ((i4) & 1))
    const bf16_t* Pgv = P + r0 * LDP + S_GV; bf16_t* Pya = P + r0 * LDP + S_YA;
    const float* lngb = a.in[I_LNG] + (size_t)l * 1024; const float* lnbb = a.in[I_LNB] + (size_t)l * 1024; const float* sgbb = a.in[I_SGB] + (size_t)l * 1024;
    const unsigned o_raw = (unsigned)(jr * LDP + cc * 8), o_w = (unsigned)(jr * 128 + cc * 8), o_az = (unsigned)(fr * LDP + blk * 32 + fq * 8);
#define MA_PREFETCH(G) do { \
        const bf16_t* pg_ = Pgv + (G) * 128; const bf16_t* wg_ = SGW + (size_t)(G) * 16384; const bf16_t* pa_ = Pya + (G) * 128 + hrow * 32 * LDP; \
        _Pragma("unroll") for (int i_ = 0; i_ < 4; ++i_) { raw[i_] = *(const u32x4*)(pg_ + i_ * 32 * LDP + o_raw); wreg[i_] = *(const u32x4*)(wg_ + i_ * 32 * 128 + o_w); } \
        { const float* lg_ = lngb + (G) * 128; const float* lb_ = lnbb + (G) * 128; \
          lnp[0] = *(const f32x4*)(lg_ + cc * 8); lnp[1] = *(const f32x4*)(lg_ + cc * 8 + 4); lnp[2] = *(const f32x4*)(lb_ + cc * 8); lnp[3] = *(const f32x4*)(lb_ + cc * 8 + 4); } \
        _Pragma("unroll") for (int i4_ = 0; i4_ < 4; ++i4_) { \
            az_n[i4_] = *(const u32x4*)(pa_ + ITL(i4_) * 16 * LDP + o_az); \
            bias_n[i4_] = sgbb[(G) * 128 + hrow * 32 + ITL(i4_) * 16 + fr]; } } while (0)
    MA_PREFETCH(0);
    u32x4 qa[2][8][2];
#pragma unroll
    for (int h = 0; h < 2; ++h)
#pragma unroll
        for (int jj = 0; jj < 8; ++jj) { const bf16_t* rp = Pgv + (wave * 16 + h * 8 + jj) * LDP; qa[h][jj][0] = *(const u32x4*)(rp + lane * 8); qa[h][jj][1] = *(const u32x4*)(rp + 512 + lane * 8); }
#pragma unroll
    for (int h = 0; h < 2; ++h) {
        u32x4 (&qq)[8][2] = qa[h];
        float sm[8];
#pragma unroll
        for (int jj = 0; jj < 8; ++jj) { float t = 0.f;
#pragma unroll
            for (int w = 0; w < 2; ++w) { const u32x4 z = qq[jj][w]; t += (bf_lo(z.x) + bf_hi(z.x)) + (bf_lo(z.y) + bf_hi(z.y)) + (bf_lo(z.z) + bf_hi(z.z)) + (bf_lo(z.w) + bf_hi(z.w)); }
            sm[jj] = t; }
#pragma unroll
        for (int o = 1; o < 64; o <<= 1)
#pragma unroll
            for (int jj = 0; jj < 8; ++jj) sm[jj] += __shfl_xor(sm[jj], o);
        float s2[8];
#pragma unroll
        for (int jj = 0; jj < 8; ++jj) { const float mean = sm[jj] * (1.f / 1024.f); sm[jj] = mean; float t = 0.f;
#pragma unroll
            for (int w = 0; w < 2; ++w) { const u32x4 z = qq[jj][w]; float d;
                d = bf_lo(z.x) - mean; t += d * d; d = bf_hi(z.x) - mean; t += d * d; d = bf_lo(z.y) - mean; t += d * d; d = bf_hi(z.y) - mean; t += d * d;
                d = bf_lo(z.z) - mean; t += d * d; d = bf_hi(z.z) - mean; t += d * d; d = bf_lo(z.w) - mean; t += d * d; d = bf_hi(z.w) - mean; t += d * d; }
            s2[jj] = t; }
#pragma unroll
        for (int o = 1; o < 64; o <<= 1)
#pragma unroll
            for (int jj = 0; jj < 8; ++jj) s2[jj] += __shfl_xor(s2[jj], o);
#pragma unroll
        for (int jj = 0; jj < 8; ++jj) if (lane == jj) stat[wave * 16 + h * 8 + jj] = (f32x2){sm[jj], 1.0f / sqrtf(s2[jj] * (1.f / 1024.f) + LN_EPS)};
    }
    __syncthreads();
#pragma unroll 1
    for (int g = 0; g < 8; ++g) {
        LAS bf16_t* vn = vn0 + (g & 1) * VBUF;
        LAS bf16_t* wsm = wsm0 + (g & 1) * WBUF;
        {
            const f32x4 g0 = lnp[0], g1 = lnp[1], b0 = lnp[2], b1 = lnp[3];
#pragma unroll
            for (int i = 0; i < 4; ++i) {
                const int j = jr + 32 * i; const u32x4 q = raw[i]; const f32x2 st = stat[j];
                float y[8];
                y[0] = (bf_lo(q.x) - st.x) * st.y * g0.x + b0.x; y[1] = (bf_hi(q.x) - st.x) * st.y * g0.y + b0.y;
                y[2] = (bf_lo(q.y) - st.x) * st.y * g0.z + b0.z; y[3] = (bf_hi(q.y) - st.x) * st.y * g0.w + b0.w;
                y[4] = (bf_lo(q.z) - st.x) * st.y * g1.x + b1.x; y[5] = (bf_hi(q.z) - st.x) * st.y * g1.y + b1.y;
                y[6] = (bf_lo(q.w) - st.x) * st.y * g1.z + b1.z; y[7] = (bf_hi(q.w) - st.x) * st.y * g1.w + b1.w;
                u32x2 w0, w1; w0.x = cvt_pk_bf16(y[0], y[1]); w0.y = cvt_pk_bf16(y[2], y[3]); w1.x = cvt_pk_bf16(y[4], y[5]); w1.y = cvt_pk_bf16(y[6], y[7]);
                *(LAS u32x2*)(vn + j * VS + 32 * (cc >> 2) + 4 * (cc & 3)) = w0; *(LAS u32x2*)(vn + j * VS + 32 * (cc >> 2) + 16 + 4 * (cc & 3)) = w1;
                *(LAS u32x4*)(wsm + j * WSS + cc * 8) = wreg[i];
            }
        }
        u32x4 az_c[4]; float bias_c[4];
#pragma unroll
        for (int i4 = 0; i4 < 4; ++i4) { az_c[i4] = az_n[i4]; bias_c[i4] = bias_n[i4]; }
        if (g < 7) MA_PREFETCH(g + 1);
        __syncthreads();
        bf16x8 vf[2][4];
        {
            const unsigned tra = (unsigned)(size_t)vn + (unsigned)(((fq * 8 + (fr >> 2)) * VS + blk * 32 + 4 * (fr & 3)) * 2);
            s16x4 t0, t1, t2, t3, t4, t5, t6, t7, u0, u1, u2, u3, u4, u5, u6, u7;
            asm volatile("ds_read_b64_tr_b16 %0, %16\n\t"
                         "ds_read_b64_tr_b16 %1, %16 offset:1056\n\t"
                         "ds_read_b64_tr_b16 %2, %16 offset:8448\n\t"
                         "ds_read_b64_tr_b16 %3, %16 offset:9504\n\t"
                         "ds_read_b64_tr_b16 %4, %16 offset:16896\n\t"
                         "ds_read_b64_tr_b16 %5, %16 offset:17952\n\t"
                         "ds_read_b64_tr_b16 %6, %16 offset:25344\n\t"
                         "ds_read_b64_tr_b16 %7, %16 offset:26400\n\t"
                         "ds_read_b64_tr_b16 %8, %16 offset:32\n\t"
                         "ds_read_b64_tr_b16 %9, %16 offset:1088\n\t"
                         "ds_read_b64_tr_b16 %10, %16 offset:8480\n\t"
                         "ds_read_b64_tr_b16 %11, %16 offset:9536\n\t"
                         "ds_read_b64_tr_b16 %12, %16 offset:16928\n\t"
                         "ds_read_b64_tr_b16 %13, %16 offset:17984\n\t"
                         "ds_read_b64_tr_b16 %14, %16 offset:25376\n\t"
                         "ds_read_b64_tr_b16 %15, %16 offset:26432\n\t"
                         "s_waitcnt lgkmcnt(0)"
                         : "=&v"(t0), "=&v"(t1), "=&v"(t2), "=&v"(t3), "=&v"(t4), "=&v"(t5), "=&v"(t6), "=&v"(t7),
                           "=&v"(u0), "=&v"(u1), "=&v"(u2), "=&v"(u3), "=&v"(u4), "=&v"(u5), "=&v"(u6), "=&v"(u7) : "v"(tra) : "memory");
            vf[0][0] = __builtin_shufflevector(t0, t1, 0, 1, 2, 3, 4, 5, 6, 7); vf[0][1] = __builtin_shufflevector(t2, t3, 0, 1, 2, 3, 4, 5, 6, 7);
            vf[0][2] = __builtin_shufflevector(t4, t5, 0, 1, 2, 3, 4, 5, 6, 7); vf[0][3] = __builtin_shufflevector(t6, t7, 0, 1, 2, 3, 4, 5, 6, 7);
            vf[1][0] = __builtin_shufflevector(u0, u1, 0, 1, 2, 3, 4, 5, 6, 7); vf[1][1] = __builtin_shufflevector(u2, u3, 0, 1, 2, 3, 4, 5, 6, 7);
            vf[1][2] = __builtin_shufflevector(u4, u5, 0, 1, 2, 3, 4, 5, 6, 7); vf[1][3] = __builtin_shufflevector(u6, u7, 0, 1, 2, 3, 4, 5, 6, 7);
        }
        f32x4 acc[4][2];
#pragma unroll
        for (int i4 = 0; i4 < 4; ++i4) { acc[i4][0] = (f32x4){0.f, 0.f, 0.f, 0.f}; acc[i4][1] = (f32x4){0.f, 0.f, 0.f, 0.f}; }
        const LAS bf16_t* wl = wsm + (hrow * 32 + fr) * WSS + fq * 8;
#pragma unroll
        for (int i4 = 0; i4 < 4; ++i4)
#pragma unroll
            for (int k = 0; k < 4; ++k) {
                if (i4 < 2 && k >= 2) continue;
                const bf16x8 wf = *(const LAS bf16x8*)(wl + ITL(i4) * 16 * WSS + k * 32);
                acc[i4][0] = __builtin_amdgcn_mfma_f32_16x16x32_bf16(vf[0][k], wf, acc[i4][0], 0, 0, 0);
                acc[i4][1] = __builtin_amdgcn_mfma_f32_16x16x32_bf16(vf[1][k], wf, acc[i4][1], 0, 0, 0);
            }
#pragma unroll
        for (int i4 = 0; i4 < 4; ++i4) {
            const u32x4 z = az_c[i4]; const float bs = bias_c[i4];
            u32x4 w;
            w.x = cvt_pk_bf16((acc[i4][0][0] + bs) * bf_lo(z.x), (acc[i4][0][1] + bs) * bf_hi(z.x));
            w.y = cvt_pk_bf16((acc[i4][0][2] + bs) * bf_lo(z.y), (acc[i4][0][3] + bs) * bf_hi(z.y));
            w.z = cvt_pk_bf16((acc[i4][1][0] + bs) * bf_lo(z.z), (acc[i4][1][1] + bs) * bf_hi(z.z));
            w.w = cvt_pk_bf16((acc[i4][1][2] + bs) * bf_lo(z.w), (acc[i4][1][3] + bs) * bf_hi(z.w));
            *(u32x4*)(Pya + g * 128 + (hrow * 32 + ITL(i4) * 16) * LDP + o_az) = w;
        }
    }
#undef MA_PREFETCH
#undef ITL
    __syncthreads();
}

template <int GI> struct PoolCfg { static constexpr int WIN = 2 << GI, NV = WIN + 7; };
template <int GI>
__device__ __forceinline__ void pool_load(const bf16_t* P, size_t r0, int pos0, int tid, u32x4 (&v)[PoolCfg<GI>::NV]) {
    constexpr int WIN = PoolCfg<GI>::WIN, NV = PoolCfg<GI>::NV;
    const int tseg = tid >> 5, cch = tid & 31;
    const int p_first = pos0 + tseg * 8 - (WIN - 1);
    const bf16_t* base = P + r0 * LDP + S_BP + GI * 256;
    const unsigned off = (unsigned)(tseg * 8 * LDP + cch * 8);
#pragma unroll
    for (int i = 0; i < NV; ++i) {
        if (p_first + i >= 0) v[i] = *(const u32x4*)(base + (long)(i - (WIN - 1)) * LDP + off);
        else v[i] = (u32x4){0u, 0u, 0u, 0u};
    }
}
template <int GI>
__device__ __forceinline__ void pool_compute(const u32x4 (&v)[PoolCfg<GI>::NV], LAS bf16_t* dt, int pos0, int tid) {
    constexpr int WIN = PoolCfg<GI>::WIN, DS = 264;
    const int tseg = tid >> 5, cch = tid & 31;
    float inv[8];
#pragma unroll
    for (int t = 0; t < 8; ++t) { const int sp = pos0 + tseg * 8 + t; inv[t] = 1.0f / (float)((sp + 1 < WIN) ? (sp + 1) : WIN); }
    u32x4 o[8];
#pragma unroll
    for (int w = 0; w < 4; ++w) {
        float rl = 0.f, rh = 0.f;
#pragma unroll
        for (int i = 0; i < WIN - 1; ++i) { rl += bf_lo(v[i][w]); rh += bf_hi(v[i][w]); }
#pragma unroll
        for (int t = 0; t < 8; ++t) {
            const float pl = bf_lo(v[WIN - 1 + t][w]), ph = bf_hi(v[WIN - 1 + t][w]);
            rl += pl; rh += ph;
            o[t][w] = cvt_pk_bf16(rl * inv[t] - pl, rh * inv[t] - ph);
            rl -= bf_lo(v[t][w]); rh -= bf_hi(v[t][w]);
        }
    }
#pragma unroll
    for (int t = 0; t < 8; ++t) *(LAS u32x4*)(dt + (tseg * 8 + t) * DS + cch * 8) = o[t];
}

template <int GI, int NVN>
__device__ __forceinline__ void bc_group(const Args& a, LAS bf16_t* dt, bf16_t* P, int l, size_t r0, int pos0, int tid, const u32x4 (&v_cur)[PoolCfg<GI>::NV], u32x4 (&v_nxt)[NVN]) {
    constexpr int DS = 264, g = GI;
    const int lane = tid & 63, wave = __builtin_amdgcn_readfirstlane(tid >> 6), fr = lane & 15, fq = lane >> 4;
    const bf16_t* pw = (const bf16_t*)(a.ws + WS_POOL) + (size_t)g * 65536 + wave * 32 * 256;
    const unsigned o_w = (unsigned)((8 * (fr >> 2) + (fr & 3)) * 256 + fq * 8);
    bf16x8 bfr[2][8];
#pragma unroll
    for (int n = 0; n < 2; ++n)
#pragma unroll
        for (int k = 0; k < 8; ++k) bfr[n][k] = *(const bf16x8*)(pw + n * 4 * 256 + k * 32 + o_w);
    pool_compute<GI>(v_cur, dt, pos0, tid);
    bf16_t* pz = P + r0 * LDP + S_BZ + g * 256 + wave * 32;
    const unsigned o_z = (unsigned)(fr * LDP + fq * 8);
    u32x4 z[8];
#pragma unroll
    for (int mt = 0; mt < 8; ++mt) z[mt] = *(const u32x4*)(pz + mt * 16 * LDP + o_z);
    __syncthreads();
    f32x4 acc[8][2];
#pragma unroll
    for (int mt = 0; mt < 8; ++mt) { acc[mt][0] = (f32x4){0.f, 0.f, 0.f, 0.f}; acc[mt][1] = (f32x4){0.f, 0.f, 0.f, 0.f}; }
#pragma unroll
    for (int mt = 0; mt < 8; ++mt)
#pragma unroll
        for (int k = 0; k < 8; ++k) {
            const bf16x8 af = *(const LAS bf16x8*)(dt + (mt * 16 + fr) * DS + k * 32 + fq * 8);
            acc[mt][0] = __builtin_amdgcn_mfma_f32_16x16x32_bf16(bfr[0][k], af, acc[mt][0], 0, 0, 0);
            acc[mt][1] = __builtin_amdgcn_mfma_f32_16x16x32_bf16(bfr[1][k], af, acc[mt][1], 0, 0, 0);
        }
    if constexpr (GI < 3) pool_load<GI + 1>(P, r0, pos0, tid, v_nxt);
    {
        const int c = g * 256 + wave * 32 + 8 * fq;
        const float* pbp = a.in[I_POOLB] + (size_t)l * 1024 + c; const float* psp = a.in[I_POOLS] + (size_t)l * 1024 + c;
        const f32x4 pb0 = *(const f32x4*)pbp, pb1 = *(const f32x4*)(pbp + 4), ps0 = *(const f32x4*)psp, ps1 = *(const f32x4*)(psp + 4);
#pragma unroll
        for (int mt = 0; mt < 8; ++mt) {
            const u32x4 zz = z[mt];
            u32x4 w;
            w.x = cvt_pk_bf16((acc[mt][0][0] + pb0.x) * ps0.x * bf_lo(zz.x), (acc[mt][0][1] + pb0.y) * ps0.y * bf_hi(zz.x));
            w.y = cvt_pk_bf16((acc[mt][0][2] + pb0.z) * ps0.z * bf_lo(zz.y), (acc[mt][0][3] + pb0.w) * ps0.w * bf_hi(zz.y));
            w.z = cvt_pk_bf16((acc[mt][1][0] + pb1.x) * ps1.x * bf_lo(zz.z), (acc[mt][1][1] + pb1.y) * ps1.y * bf_hi(zz.z));
            w.w = cvt_pk_bf16((acc[mt][1][2] + pb1.z) * ps1.z * bf_lo(zz.w), (acc[mt][1][3] + pb1.w) * ps1.w * bf_hi(zz.w));
            *(u32x4*)(pz + mt * 16 * LDP + o_z) = w;
        }
    }
    __syncthreads();
}

__device__ __forceinline__ void mixer_bc(const Args& a, LAS unsigned char* lds, bf16_t* P, int l, int nb) {
    int tid = threadIdx.x; asm volatile("" : "+v"(tid));
    LAS bf16_t* dt = (LAS bf16_t*)lds;
    const size_t r0 = (size_t)nb * 128;
    const int pos0 = (nb & 127) * 128;
    {
        u32x4 v0[PoolCfg<0>::NV], v1[PoolCfg<1>::NV], v2[PoolCfg<2>::NV], v3[PoolCfg<3>::NV];
        pool_load<0>(P, r0, pos0, tid, v0);
        bc_group<0>(a, dt, P, l, r0, pos0, tid, v0, v1);
        bc_group<1>(a, dt, P, l, r0, pos0, tid, v1, v2);
        bc_group<2>(a, dt, P, l, r0, pos0, tid, v2, v3);
        bc_group<3>(a, dt, P, l, r0, pos0, tid, v3, v0);
    }
    {
        const int cc = tid & 127, c = cc * 8, t0 = (tid >> 7) * 32;
        float w0[8], w1[8], w2[8], cb[8], qm1[8], qm2[8];
        const float* cw = a.in[I_CONVW] + (size_t)l * 3 * 1024 + c; const float* cbp = a.in[I_CONVB] + (size_t)l * 1024 + c;
        {
            const f32x4 a0 = *(const f32x4*)cw, a1 = *(const f32x4*)(cw + 4), b0 = *(const f32x4*)(cw + 1024), b1 = *(const f32x4*)(cw + 1028);
            const f32x4 c0 = *(const f32x4*)(cw + 2048), c1 = *(const f32x4*)(cw + 2052), d0 = *(const f32x4*)cbp, d1 = *(const f32x4*)(cbp + 4);
#pragma unroll
            for (int e = 0; e < 4; ++e) { w0[e] = a0[e]; w0[4 + e] = a1[e]; w1[e] = b0[e]; w1[4 + e] = b1[e]; w2[e] = c0[e]; w2[4 + e] = c1[e]; cb[e] = d0[e]; cb[4 + e] = d1[e]; }
#pragma unroll
            for (int e = 0; e < 8; ++e) { qm1[e] = 0.f; qm2[e] = 0.f; }
        }
        bf16_t* bp = P + (r0 + t0) * LDP + c;
        if (pos0 + t0 >= 2) {
            const u32x4 h1 = *(const u32x4*)(bp - LDP + S_Q), h2 = *(const u32x4*)(bp - 2 * LDP + S_Q);
            qm1[0] = bf_lo(h1.x); qm1[1] = bf_hi(h1.x); qm1[2] = bf_lo(h1.y); qm1[3] = bf_hi(h1.y); qm1[4] = bf_lo(h1.z); qm1[5] = bf_hi(h1.z); qm1[6] = bf_lo(h1.w); qm1[7] = bf_hi(h1.w);
            qm2[0] = bf_lo(h2.x); qm2[1] = bf_hi(h2.x); qm2[2] = bf_lo(h2.y); qm2[3] = bf_hi(h2.y); qm2[4] = bf_lo(h2.z); qm2[5] = bf_hi(h2.z); qm2[6] = bf_lo(h2.w); qm2[7] = bf_hi(h2.w);
        }
        u32x4 qv[3][4], zv[3][4];
#pragma unroll
        for (int pb = 0; pb < 2; ++pb)
#pragma unroll
            for (int t = 0; t < 4; ++t) { const bf16_t* rp = bp + (size_t)(pb * 4 + t) * LDP; qv[pb][t] = *(const u32x4*)(rp + S_Q); zv[pb][t] = *(const u32x4*)(rp + S_CBZ); }
#pragma unroll
        for (int bt = 0; bt < 8; ++bt) {
            if (bt < 6) {
#pragma unroll
                for (int t = 0; t < 4; ++t) { const bf16_t* rp = bp + (size_t)((bt + 2) * 4 + t) * LDP; qv[(bt + 2) % 3][t] = *(const u32x4*)(rp + S_Q); zv[(bt + 2) % 3][t] = *(const u32x4*)(rp + S_CBZ); }
            }
#pragma unroll
            for (int t = 0; t < 4; ++t) {
                const u32x4 qq = qv[bt % 3][t], zq = zv[bt % 3][t];
                float q[8], z[8], o[8];
                q[0] = bf_lo(qq.x); q[1] = bf_hi(qq.x); q[2] = bf_lo(qq.y); q[3] = bf_hi(qq.y); q[4] = bf_lo(qq.z); q[5] = bf_hi(qq.z); q[6] = bf_lo(qq.w); q[7] = bf_hi(qq.w);
                z[0] = bf_lo(zq.x); z[1] = bf_hi(zq.x); z[2] = bf_lo(zq.y); z[3] = bf_hi(zq.y); z[4] = bf_lo(zq.z); z[5] = bf_hi(zq.z); z[6] = bf_lo(zq.w); z[7] = bf_hi(zq.w);
#pragma unroll
                for (int e = 0; e < 8; ++e) { o[e] = z[e] * (w0[e] * qm2[e] + w1[e] * qm1[e] + w2[e] * q[e] + cb[e]); qm2[e] = qm1[e]; qm1[e] = q[e]; }
                u32x4 w; w.x = cvt_pk_bf16(o[0], o[1]); w.y = cvt_pk_bf16(o[2], o[3]); w.z = cvt_pk_bf16(o[4], o[5]); w.w = cvt_pk_bf16(o[6], o[7]);
                *(u32x4*)(bp + (size_t)(bt * 4 + t) * LDP + S_CBZ) = w;
            }
        }
    }
    __syncthreads();
}

constexpr int WGM_P1 = 4, WGM_P3 = 8, WGM_P4 = 8;
constexpr int PH_PER_LAYER = 5, N_PHASES = DEPTH * PH_PER_LAYER + 1;

__global__ void __launch_bounds__(NTHREADS, 2) fwd_kernel(Args a) {
    extern __shared__ __attribute__((aligned(16))) unsigned char lds_raw[];
    LAS unsigned char* lds = (LAS unsigned char*)lds_raw;
    cg::grid_group grid = cg::this_grid();
    const int G = gridDim.x;
    volatile LAS unsigned* misc = (volatile LAS unsigned*)(lds + LDS_MISC);
    if (threadIdx.x < 2) misc[threadIdx.x] = 0u;
    __syncthreads();
    XcdBarrier xbar; xbar.bar = (unsigned*)(a.ws + WS_BAR); xbar.x = 0; xbar.st = misc;
    if (a.ph_hi - a.ph_lo > 1) xbar = xcd_barrier_post((unsigned*)(a.ws + WS_BAR), misc);
    bf16_t* P = (bf16_t*)(a.ws + WS_P);
    for (int ph = a.ph_lo; ph < a.ph_hi; ++ph) {
        if (ph == N_PHASES - 1) {
            int tid = threadIdx.x; asm volatile("" : "+v"(tid));
            const int wave = __builtin_amdgcn_readfirstlane(tid >> 6);
            rms_rows_xr<false>((const bf16_t*)(a.ws + WS_XR), a.in[I_FINALG], a.out, blockIdx.x * NWAVES + wave, G * NWAVES, tid & 63);
        } else {
            const int l = ph / PH_PER_LAYER, k = ph - l * PH_PER_LAYER;
            if (k == 0) phase_p0(a, lds, l);
            else if (k == 1) {
                pg8::Gemm g{(const bf16_t*)(a.ws + WS_H), (const bf16_t*)(a.ws + WS_WIN), DM, DM, 0, 0};
                pg8::TileOrder S; S.init(MTOK, NIN, G, (int)blockIdx.x, 1, WGM_P1);
                pg8::EpiProj E{P};
                pg8::gemm_phase<pg8::EpiProj, pg8::TileOrder>(lds, g, S, E);
            } else if (k == 2) {
                for (int u = blockIdx.x; u < 512; u += G) { const int nb = u & 255; const bool bc_first = (nb & 1) != 0; const bool second = (u >= 256);
                    if (bc_first != second) mixer_bc(a, lds, P, l, nb); else mixer_a(a, lds, P, l, nb); }
            } else if (k == 3) {
                pg8::Gemm g{P + S_YA, (const bf16_t*)(a.ws + WS_WABC), LDP, DM, (size_t)Y_STRIDE, (size_t)DM * DM};
                pg8::TileOrder S; S.init(MTOK, DM, G, (int)blockIdx.x, 3, WGM_P3);
                pg8::EpiGate E{P};
                pg8::gemm_phase<pg8::EpiGate, pg8::TileOrder>(lds, g, S, E);
            } else {
                pg8::Gemm g{P + S_MG, (const bf16_t*)(a.ws + WS_WOUT), LDP, DM, 0, 0};
                pg8::TileOrder S; S.init(MTOK, DM, G, (int)blockIdx.x, 1, WGM_P4);
                pg8::EpiRes E{(bf16_t*)(a.ws + WS_XR)};
                pg8::gemm_phase<pg8::EpiRes, pg8::TileOrder>(lds, g, S, E);
            }
        }
        if (ph + 1 < a.ph_hi) { if (a.ph_hi < 0) grid.sync(); xcd_barrier(xbar); }
    }
}

extern "C" void kernel_launch(void* const* d_in, const int* in_sizes, int n_in, void* d_out, int out_size, void* d_ws, size_t ws_size, hipStream_t stream) {
    static int grid = 0;
    if (grid == 0) {
        if (n_in != 17 || in_sizes[0] != MTOK * DM || out_size != MTOK * DM || ws_size < WS_END) {
            fprintf(stderr, "kernel_launch: unexpected problem (n_in %d, in0 %d, out %d, ws %zu); nothing launched\n", n_in, n_in > 0 ? in_sizes[0] : -1, out_size, ws_size); grid = -1; return; }
        int dev = 0, cus = 0, per_cu = 0;
        if (hipGetDevice(&dev) != hipSuccess || hipDeviceGetAttribute(&cus, hipDeviceAttributeMultiprocessorCount, dev) != hipSuccess) { fprintf(stderr, "kernel_launch: device query failed\n"); grid = -1; return; }
        if (hipFuncSetAttribute((const void*)fwd_kernel, hipFuncAttributeMaxDynamicSharedMemorySize, LDS_BYTES) != hipSuccess) { fprintf(stderr, "kernel_launch: hipFuncSetAttribute failed\n"); grid = -1; return; }
        if (hipOccupancyMaxActiveBlocksPerMultiprocessor(&per_cu, (const void*)fwd_kernel, NTHREADS, LDS_BYTES) != hipSuccess || per_cu < 1) { fprintf(stderr, "kernel_launch: occupancy query says %d blocks/CU\n", per_cu); per_cu = 1; }
        (void)hipGetLastError();
        grid = cus * per_cu;
    }
    if (grid < 0) return;
    Args a{};
    for (int i = 0; i < 17; ++i) a.in[i] = (const float*)d_in[i];
    a.out = (float*)d_out; a.ws = (unsigned char*)d_ws;
#if MK_MULTI_LAUNCH
    for (int ph = 0; ph < N_PHASES; ++ph) {
        a.ph_lo = ph; a.ph_hi = ph + 1;
        hipLaunchKernelGGL(fwd_kernel, dim3(grid), dim3(NTHREADS), LDS_BYTES, stream, a);
    }
#else
    if (hipMemsetAsync((char*)d_ws + WS_BAR, 0, 16384, stream) != hipSuccess) { fprintf(stderr, "kernel_launch: memset of the barrier words failed\n"); return; }
    a.ph_lo = 0; a.ph_hi = N_PHASES;
    void* kargs[] = {&a};
    hipError_t e = hipLaunchCooperativeKernel((const void*)fwd_kernel, dim3(grid), dim3(NTHREADS), kargs, LDS_BYTES, stream);
    if (e != hipSuccess) fprintf(stderr, "kernel_launch: cooperative launch failed: %s (grid %d)\n", hipGetErrorString(e), grid);
#endif
}
```
